# Optimizing an MI355X kernel written in HIP

```python
import math
import jax, jax.numpy as jnp
from jax import lax
import numpy as np

D_MODEL = 1024
BATCH = 4
SEQ = 4096
DEPTH = 4

CTX_LEN = 256
GRID_W = 64
POOL_WIDTH = 512
POOL_WINDOWS = (2, 4, 8, 16)
POOL_GROUPS = len(POOL_WINDOWS)
POOL_GC = POOL_WIDTH // POOL_GROUPS
N_HEADS = 4
HEAD_DIM = 64
V_DIM = 2 * HEAD_DIM
QK_WIDTH = N_HEADS * 2 * HEAD_DIM
ATTN_WIDTH = N_HEADS * V_DIM
MIX_WIDTH = POOL_WIDTH + ATTN_WIDTH
IN_WIDTH = POOL_WIDTH + 2 * QK_WIDTH + ATTN_WIDTH
ROT_AXIS = HEAD_DIM // 2
ROPE_BASE = 10000.0
D_FF = 4 * D_MODEL
Q_BLOCK = 128
N_ADA = 6
EPS = 1e-6

kernel_name = "hybrid_pool_diffattn_dit_block"


def rms_norm(x, g):
    xf = x.astype(jnp.float32)
    y = xf * lax.rsqrt(jnp.mean(xf * xf, axis=-1, keepdims=True) + EPS)
    return (y * g.astype(jnp.float32)).astype(x.dtype)


def modulate(h, shift, scale):
    return h * (1 + scale) + shift


def ada_params(cvec, w_ada, b_ada):
    return jnp.split(jax.nn.silu(cvec) @ w_ada + b_ada, N_ADA, axis=-1)


def axial_rope(n, dtype):
    rows = n // GRID_W
    row = jnp.repeat(jnp.arange(rows), GRID_W).astype(jnp.float32)
    col = jnp.tile(jnp.arange(GRID_W), rows).astype(jnp.float32)
    inv = ROPE_BASE ** (-jnp.arange(0, ROT_AXIS, 2, dtype=jnp.float32) / ROT_AXIS)
    ang = jnp.concatenate([row[:, None] * inv, col[:, None] * inv], axis=-1)
    return jnp.cos(ang).astype(dtype), jnp.sin(ang).astype(dtype)


def apply_rope(x, cos, sin):
    x1, x2 = x[..., :HEAD_DIM // 2], x[..., HEAD_DIM // 2:]
    return jnp.concatenate([x1 * cos - x2 * sin, x1 * sin + x2 * cos], axis=-1)


def centred_mean(x, w):
    b, n, ch = x.shape
    xf = x.astype(jnp.float32)
    cs = jnp.concatenate([jnp.zeros((b, 1, ch), jnp.float32), jnp.cumsum(xf, axis=1)], axis=1)
    t = jnp.arange(n)
    lo = jnp.clip(t - w // 2, 0, n)
    hi = jnp.clip(t + w - w // 2, 0, n)
    s = cs[:, hi] - cs[:, lo]
    cnt = (hi - lo).astype(jnp.float32)
    return (s / cnt[None, :, None]).astype(x.dtype)


def pool_mixer(u, w_pool, s_pool):
    b, n, _ = u.shape
    groups = jnp.split(u, POOL_GROUPS, axis=-1)
    y = jnp.stack([centred_mean(g, w) - g for g, w in zip(groups, POOL_WINDOWS)], axis=2)
    y = jnp.einsum('bngc,gcd->bngd', y, w_pool).reshape(b, n, POOL_WIDTH)
    return y * s_pool


def split_heads(z):
    b, n, _ = z.shape
    u, q, k, v = jnp.split(z, [POOL_WIDTH, POOL_WIDTH + QK_WIDTH, POOL_WIDTH + 2 * QK_WIDTH], axis=-1)
    q = q.reshape(b, n, 2 * N_HEADS, HEAD_DIM).transpose(0, 2, 1, 3)
    k = k.reshape(b, n, 2 * N_HEADS, HEAD_DIM).transpose(0, 2, 1, 3)
    v = v.reshape(b, n, N_HEADS, V_DIM).transpose(0, 2, 1, 3)
    return u, q, k, v


def diff_attn(q, k, v, lam):
    b, _, nq, _ = q.shape
    nk = k.shape[2]
    s = jnp.einsum('bhqd,bhkd->bhqk', q, k).astype(jnp.float32) * (HEAD_DIM ** -0.5)
    a = jax.nn.softmax(s, axis=-1).reshape(b, N_HEADS, 2, nq, nk)
    w = a[:, :, 0] - lam * a[:, :, 1]
    return jnp.einsum('bhqk,bhkd->bhqd', w.astype(v.dtype), v)


def diff_attn_blocks(q, k, v, lam):
    b, hh, n, d = q.shape
    nb = n // Q_BLOCK
    qb = q.reshape(b, hh, nb, Q_BLOCK, d).transpose(2, 0, 1, 3, 4)
    o = lax.map(lambda qblk: diff_attn(qblk, k, v, lam), qb)
    return o.transpose(1, 2, 0, 3, 4).reshape(b, N_HEADS, n, V_DIM)


def head_out(o, g_sub, lam_init):
    o = rms_norm(o, g_sub) * (1.0 - lam_init)
    b, h, n, d = o.shape
    return o.transpose(0, 2, 1, 3).reshape(b, n, h * d)


def sq_relu_mlp(h, w1, w2):
    return jnp.square(jax.nn.relu(h @ w1)) @ w2


def setup_inputs(seed: int = 0) -> dict:
    key = jax.random.key(seed)
    ks = jax.random.split(key, 24)
    f = jnp.float32
    nrm = lambda k, shape, s: jax.random.normal(k, shape, f) * s
    L = DEPTH
    return {
        "x": nrm(ks[0], (BATCH, SEQ, D_MODEL), 1.0),
        "c": nrm(ks[1], (BATCH, D_MODEL), 1.0),
        "ctx": nrm(ks[2], (BATCH, CTX_LEN, D_MODEL), 1.0),
        "c_ctx": nrm(ks[3], (D_MODEL,), 1.0),
        "w_ada": nrm(ks[4], (L, D_MODEL, N_ADA * D_MODEL), 0.02),
        "b_ada": nrm(ks[5], (L, N_ADA * D_MODEL), 0.01),
        "g_mix": 1.0 + nrm(ks[6], (L, D_MODEL), 0.02),
        "g_mlp": 1.0 + nrm(ks[7], (L, D_MODEL), 0.02),
        "w_in": nrm(ks[8], (L, D_MODEL, IN_WIDTH), D_MODEL ** -0.5),
        "w_pool": nrm(ks[9], (L, POOL_GROUPS, POOL_GC, POOL_GC), POOL_GC ** -0.5),
        "s_pool": 1.0 + nrm(ks[10], (L, POOL_WIDTH), 0.1),
        "lam_q1": nrm(ks[11], (L, HEAD_DIM), 0.1),
        "lam_k1": nrm(ks[12], (L, HEAD_DIM), 0.1),
        "lam_q2": nrm(ks[13], (L, HEAD_DIM), 0.1),
        "lam_k2": nrm(ks[14], (L, HEAD_DIM), 0.1),
        "g_subln": 1.0 + nrm(ks[15], (L, V_DIM), 0.02),
        "w_out": nrm(ks[16], (L, MIX_WIDTH, D_MODEL), MIX_WIDTH ** -0.5),
        "w_mlp1": nrm(ks[17], (L, D_MODEL, D_FF), D_MODEL ** -0.5),
        "w_mlp2": nrm(ks[18], (L, D_FF, D_MODEL), D_FF ** -0.5),
        "g_final": 1.0 + nrm(ks[19], (D_MODEL,), 0.02),
    }


def reference(x, c, ctx, c_ctx, w_ada, b_ada, g_mix, g_mlp, w_in, w_pool, s_pool,
              lam_q1, lam_k1, lam_q2, lam_k2, g_subln, w_out, w_mlp1, w_mlp2, g_final):
    n = x.shape[1]
    cos, sin = axial_rope(n, x.dtype)
    c_lat = c[:, None, :]
    c_cx = c_ctx[None, None, :]
    for l in range(DEPTH):
        last = l == DEPTH - 1
        sa, ca, ga, sm, cm, gm = ada_params(c_lat, w_ada[l], b_ada[l])
        sa_c, ca_c, ga_c, sm_c, cm_c, gm_c = ada_params(c_cx, w_ada[l], b_ada[l])
        lam_init = 0.8 - 0.6 * math.exp(-0.3 * l)
        lam = (jnp.exp(jnp.sum(lam_q1[l].astype(jnp.float32) * lam_k1[l].astype(jnp.float32)))
               - jnp.exp(jnp.sum(lam_q2[l].astype(jnp.float32) * lam_k2[l].astype(jnp.float32)))
               + lam_init)

        h = modulate(rms_norm(x, g_mix[l]), sa, ca)
        hc = modulate(rms_norm(ctx, g_mix[l]), sa_c, ca_c)
        u, q, k, v = split_heads(h @ w_in[l])
        uc, qc, kc, vc = split_heads(hc @ w_in[l])
        q = apply_rope(q, cos, sin)
        k = apply_rope(k, cos, sin)
        k_all = jnp.concatenate([kc, k], axis=2)
        v_all = jnp.concatenate([vc, v], axis=2)
        o_att = diff_attn_blocks(q, k_all, v_all, lam)
        mix = jnp.concatenate([pool_mixer(u, w_pool[l], s_pool[l]),
                               head_out(o_att, g_subln[l], lam_init)], axis=-1)
        x = x + ga * (mix @ w_out[l])

        x = x + gm * sq_relu_mlp(modulate(rms_norm(x, g_mlp[l]), sm, cm), w_mlp1[l], w_mlp2[l])

        if not last:
            o_c = diff_attn(qc, kc, vc, lam)
            mix_c = jnp.concatenate([pool_mixer(uc, w_pool[l], s_pool[l]),
                                     head_out(o_c, g_subln[l], lam_init)], axis=-1)
            ctx = ctx + ga_c * (mix_c @ w_out[l])
            ctx = ctx + gm_c * sq_relu_mlp(modulate(rms_norm(ctx, g_mlp[l]), sm_c, cm_c),
                                           w_mlp1[l], w_mlp2[l])
    return rms_norm(x, g_final)
```

```cpp
#include <hip/hip_runtime.h>
#include <hip/hip_cooperative_groups.h>
#include <hip/hip_bf16.h>
#include <cstdio>
#include <cstdint>
namespace cg = cooperative_groups;
#ifndef REP_ATT
#define REP_ATT 1
#endif
#ifndef REP_G
#define REP_G 1
#endif
#ifndef REP_N
#define REP_N 1
#endif
#ifndef REP_SYNC
#define REP_SYNC 1
#endif
#define GSYNC() do { for (int r_ = 0; r_ < REP_SYNC; ++r_) xcd_barrier(xbar); } while (0)
namespace pg8 {
#define PG8_LAS __attribute__((address_space(3)))
typedef unsigned short bf16_t;
typedef short bf16x8 __attribute__((ext_vector_type(8)));
typedef float f32x4 __attribute__((ext_vector_type(4)));
typedef unsigned u32x4 __attribute__((ext_vector_type(4)));
constexpr int BM = 256, BK = 64, HALF = 128, HTB = HALF * BK * 2  , STAGE_BYTES = 8 * HTB, NXCD = 8, WGM = 8;

__host__ __device__ __forceinline__ int lds_byte(int r, int c) { const int st = (r >> 4) * 2 + (c >> 5), rr = r & 15, cc = c & 31, ob = rr * 64 + cc * 2; return st * 1024 + (ob ^ (((ob >> 9) & 1) << 5)); }
__host__ __device__ __forceinline__ void stage_rc(int b, int& R, int& C) { const int st = b / 1024, sb = b % 1024, swz = sb ^ (((sb >> 9) & 1) << 5); R = (st >> 1) * 16 + swz / 64; C = (st & 1) * 32 + (swz % 64) / 2; }
__host__ __device__ __forceinline__ int perm32(int rho) { const int n = rho >> 4, i = rho & 15; return 8 * (i >> 2) + 4 * n + (i & 3); }

struct Unit { int pm, pn; };
struct Gemm { const bf16_t* A; const bf16_t* Bt; int M, N, K; };

struct StaticOrder {
    int nM, nN, nwg, G, c;
    __host__ __device__ void init(int M, int N, int G_, int c_) { nM = M / BM; nN = N / BM; nwg = nM * nN; G = G_; c = c_; }
    __host__ __device__ bool next(int i, Unit& u) const {
        const long L = (long)i * G + c; if (L >= nwg) return false;
        int wgid = (int)L; { const int q = nwg / NXCD, r = nwg % NXCD, xcd = wgid % NXCD, off = wgid / NXCD; wgid = (xcd < r ? xcd * (q + 1) : r * (q + 1) + (xcd - r) * q) + off; }
        const int nig = WGM * nN, gid = wgid / nig, fm = gid * WGM, gsz = (nM - fm) < WGM ? (nM - fm) : WGM;
        u.pm = fm + ((wgid % nig) % gsz); u.pn = (wgid % nig) / gsz; return true;
    }
    __device__ __forceinline__ void a_ready(const Unit&) const {}
    __device__ __forceinline__ void done(const Unit&) const {}
};

__device__ __forceinline__ unsigned cvt_pk_bf16(float lo, float hi) { unsigned r; asm volatile("v_cvt_pk_bf16_f32 %0, %1, %2" : "=v"(r) : "v"(lo), "v"(hi)); return r; }
typedef float f32x2 __attribute__((ext_vector_type(2)));
struct EpiInProj {
    static constexpr bool PERM = true, AFTER_DRAIN = false;
    bf16_t* Z; const float* cosT; const float* sinT;
    __device__ __forceinline__ void operator()(const f32x4 (&acc)[2][2][4][2], const Unit& u, int wr, int wc, int fr, int fq) const {
        const int row0 = u.pm * BM + wr * 64 + fr, colt = u.pn * BM, region = colt >> 9;
        const bool rope = (region == 1 || region == 2) && (u.pm < 64);
        const float sc = (region == 1) ? 0.18033688011112042f : 1.0f;
        const int col0 = colt + wc * 32 + 8 * fq, i0 = (wc & 1) * 16 + 4 * fq;
        f32x4 inv4;
#pragma unroll
        for (int jj = 0; jj < 4; ++jj) inv4[jj] = __builtin_amdgcn_exp2f(-(float)((i0 & 15) + jj) * (13.287712379549449f / 16.0f));
#pragma unroll
        for (int ai = 0; ai < 2; ++ai)
#pragma unroll
            for (int m = 0; m < 4; ++m) {
                const int row = row0 + ai * HALF + m * 16;
                f32x4 cs = (f32x4){1.f, 1.f, 1.f, 1.f}, sn = (f32x4){0.f, 0.f, 0.f, 0.f};
                if (rope) { const int t = row & 4095; const float pos = (float)((i0 < 16) ? (t >> 6) : (t & 63));
#pragma unroll
                    for (int jj = 0; jj < 4; ++jj) { const float ang = pos * inv4[jj]; cs[jj] = __cosf(ang); sn[jj] = __sinf(ang); } }
                bf16_t* rowp = Z + (size_t)row * 2048 + col0;
#pragma unroll
                for (int bj = 0; bj < 2; ++bj) {
                    const f32x4 v0 = acc[ai][bj][m][0], v1 = acc[ai][bj][m][1];
                    f32x4 o0, o1;
                    o0[0] = v0[0] * cs[0] - v0[1] * sn[0]; o0[1] = v0[0] * sn[0] + v0[1] * cs[0];
                    o0[2] = v0[2] * cs[1] - v0[3] * sn[1]; o0[3] = v0[2] * sn[1] + v0[3] * cs[1];
                    o1[0] = v1[0] * cs[2] - v1[1] * sn[2]; o1[1] = v1[0] * sn[2] + v1[1] * cs[2];
                    o1[2] = v1[2] * cs[3] - v1[3] * sn[3]; o1[3] = v1[2] * sn[3] + v1[3] * cs[3];
                    o0 = o0 * sc; o1 = o1 * sc;
                    u32x4 w; w.x = cvt_pk_bf16(o0[0], o0[1]); w.y = cvt_pk_bf16(o0[2], o0[3]); w.z = cvt_pk_bf16(o1[0], o1[1]); w.w = cvt_pk_bf16(o1[2], o1[3]);
                    *(u32x4*)(rowp + bj * HALF) = w;
                }
            }
    }
};
struct EpiSqRelu {
    static constexpr bool PERM = true, AFTER_DRAIN = false;
    bf16_t* O; int ldc;
    __device__ __forceinline__ void operator()(const f32x4 (&acc)[2][2][4][2], const Unit& u, int wr, int wc, int fr, int fq) const {
        const int row0 = u.pm * BM + wr * 64 + fr, col0 = u.pn * BM + wc * 32 + 8 * fq;
#pragma unroll
        for (int ai = 0; ai < 2; ++ai)
#pragma unroll
            for (int m = 0; m < 4; ++m) { bf16_t* rowp = O + (size_t)(row0 + ai * HALF + m * 16) * ldc + col0;
#pragma unroll
                for (int bj = 0; bj < 2; ++bj) { f32x4 v0 = acc[ai][bj][m][0], v1 = acc[ai][bj][m][1];
#pragma unroll
                    for (int j = 0; j < 4; ++j) { const float a = fmaxf(v0[j], 0.f), b = fmaxf(v1[j], 0.f); v0[j] = a * a; v1[j] = b * b; }
                    u32x4 w; w.x = cvt_pk_bf16(v0[0], v0[1]); w.y = cvt_pk_bf16(v0[2], v0[3]); w.z = cvt_pk_bf16(v1[0], v1[1]); w.w = cvt_pk_bf16(v1[2], v1[3]);
                    *(u32x4*)(rowp + bj * HALF) = w; } }
    }
};
struct EpiRes {
    static constexpr bool PERM = true, AFTER_DRAIN = false;
    const float* res_lat32; const float* res_ctx32; const bf16_t* res16; bf16_t* out16; const float* gate;
    __device__ __forceinline__ void operator()(const f32x4 (&acc)[2][2][4][2], const Unit& u, int wr, int wc, int fr, int fq) const {
        const int row0 = u.pm * BM + wr * 64 + fr, col0 = u.pn * BM + wc * 32 + 8 * fq;
        const bool lat = u.pm < 64; const int b = lat ? (u.pm >> 4) : 4;
        const float* gp = gate + (size_t)b * 6144 + col0;
        f32x4 gv[2][2];
#pragma unroll
        for (int bj = 0; bj < 2; ++bj)
#pragma unroll
            for (int n = 0; n < 2; ++n) gv[bj][n] = *(const f32x4*)(gp + bj * HALF + 4 * n);
#pragma unroll
        for (int ai = 0; ai < 2; ++ai)
#pragma unroll
            for (int m = 0; m < 4; ++m) { const int row = row0 + ai * HALF + m * 16;
                bf16_t* op = out16 + (size_t)row * 1024 + col0;
#pragma unroll
                for (int bj = 0; bj < 2; ++bj) { f32x4 r0, r1;
                    if (res16) { const u32x4 q = *(const u32x4*)(res16 + (size_t)row * 1024 + col0 + bj * HALF);
                        r0 = (f32x4){__builtin_bit_cast(float, q.x << 16), __builtin_bit_cast(float, q.x & 0xffff0000u), __builtin_bit_cast(float, q.y << 16), __builtin_bit_cast(float, q.y & 0xffff0000u)};
                        r1 = (f32x4){__builtin_bit_cast(float, q.z << 16), __builtin_bit_cast(float, q.z & 0xffff0000u), __builtin_bit_cast(float, q.w << 16), __builtin_bit_cast(float, q.w & 0xffff0000u)}; }
                    else { const float* rp = (lat ? res_lat32 + (size_t)row * 1024 : res_ctx32 + (size_t)(row - 16384) * 1024) + col0 + bj * HALF;
                        r0 = *(const f32x4*)rp; r1 = *(const f32x4*)(rp + 4); }
                    const f32x4 o0 = r0 + gv[bj][0] * acc[ai][bj][m][0], o1 = r1 + gv[bj][1] * acc[ai][bj][m][1];
                    u32x4 w; w.x = cvt_pk_bf16(o0[0], o0[1]); w.y = cvt_pk_bf16(o0[2], o0[3]); w.z = cvt_pk_bf16(o1[0], o1[1]); w.w = cvt_pk_bf16(o1[2], o1[3]);
                    *(u32x4*)(op + bj * HALF) = w; } }
    }
};
template <class Epi, class Sched, bool ALIGN_EPI = false, bool SP2 = false>
__device__ __forceinline__ void gemm_phase(PG8_LAS unsigned char* lds, const Gemm g, const Sched& S, const Epi& E) {
    int tid = threadIdx.x; asm volatile("" : "+v"(tid));
    const int wid = __builtin_amdgcn_readfirstlane(tid >> 6), lane = tid & 63, wr = wid >> 2, wc = wid & 3, fr = lane & 15, fq = lane >> 4;
    const int K = g.K, nt = K / BK;
    unsigned voffA[2], voffB[2];
#pragma unroll
    for (int i = 0; i < 2; ++i) { int R, C; stage_rc(tid * 16 + i * 8192, R, C); const int Rb = Epi::PERM ? ((R & ~31) + perm32(R & 31)) : R;
        voffA[i] = (unsigned)(R * K + C) * 2u; voffB[i] = (unsigned)(Rb * K + C) * 2u; }
    const size_t kstep = (size_t)(BK * 2);
    const size_t hstep = (size_t)HALF * K * 2;
    const size_t tstep = 2 * hstep;
    const unsigned ldsw = (unsigned)wid * 1024u;
    const int aoff = lds_byte(wr * 64 + fr, fq * 8), boff = lds_byte(wc * 32 + fr, fq * 8);
#define PG8_SA(b, h) (((b) * 2 + (h)) * HTB)
#define PG8_SB(b, h) ((4 + (b) * 2 + (h)) * HTB)
#define PG8_STAGE(bufoff, gbase, voff) do { _Pragma("unroll") for (int _i = 0; _i < 2; ++_i) \
        __builtin_amdgcn_global_load_lds((const unsigned*)((const char*)(gbase) + (voff)[_i]), (PG8_LAS unsigned*)(lds + (bufoff) + ldsw + _i * 8192), 16, 0, 0); } while (0)
#define PG8_LDA(dst, b, h) do { _Pragma("unroll") for (int m = 0; m < 4; ++m) _Pragma("unroll") for (int k = 0; k < 2; ++k) dst[m][k] = *(const PG8_LAS bf16x8*)(lds + PG8_SA(b, h) + aoff + m * 2048 + k * 1024); } while (0)
#define PG8_LDB(dst, b, h) do { _Pragma("unroll") for (int n = 0; n < 2; ++n) _Pragma("unroll") for (int k = 0; k < 2; ++k) dst[n][k] = *(const PG8_LAS bf16x8*)(lds + PG8_SB(b, h) + boff + n * 2048 + k * 1024); } while (0)
#define PG8_MMA(ai, bj, At, Bt) do { __builtin_amdgcn_s_setprio(1); _Pragma("unroll") for (int m = 0; m < 4; ++m) _Pragma("unroll") for (int n = 0; n < 2; ++n) _Pragma("unroll") for (int k = 0; k < 2; ++k) \
        acc[ai][bj][m][n] = __builtin_amdgcn_mfma_f32_16x16x32_bf16(Bt[n][k], At[m][k], acc[ai][bj][m][n], 0, 0, 0); __builtin_amdgcn_s_setprio(0); } while (0)
#define PG8_WAIT_V(n) asm volatile("s_waitcnt vmcnt(" #n ")" ::: "memory")
#define PG8_WAIT_L(n) asm volatile("s_waitcnt lgkmcnt(" #n ")" ::: "memory")
#define PG8_BAR __builtin_amdgcn_s_barrier()
#define PG8_SCHED __builtin_amdgcn_sched_barrier(0)
    Unit cur, nxt; int ui = 0;
    if (!S.next(0, cur)) return;
    f32x4 acc[2][2][4][2];
#pragma unroll
    for (int a = 0; a < 2; ++a)
#pragma unroll
        for (int b = 0; b < 2; ++b)
#pragma unroll
            for (int m = 0; m < 4; ++m)
#pragma unroll
                for (int n = 0; n < 2; ++n) acc[a][b][m][n] = (f32x4){0.f, 0.f, 0.f, 0.f};
    bf16x8 At[4][2], B0[2][2], B1[2][2];
    const char* cA = (const char*)g.A + (size_t)cur.pm * tstep; const char* cB = (const char*)g.Bt + (size_t)cur.pn * tstep;
    S.a_ready(cur);
    if constexpr (SP2) {
        PG8_STAGE(PG8_SB(0, 0), cB, voffB); PG8_STAGE(PG8_SB(0, 1), cB + hstep, voffB); PG8_STAGE(PG8_SA(0, 0), cA, voffA); PG8_STAGE(PG8_SA(0, 1), cA + hstep, voffA);
        if (wr == 1) PG8_BAR;
        PG8_WAIT_V(2); PG8_BAR;
        PG8_STAGE(PG8_SB(1, 0), cB + kstep, voffB); PG8_STAGE(PG8_SA(1, 0), cA + kstep, voffA); PG8_STAGE(PG8_SB(1, 1), cB + hstep + kstep, voffB);
        PG8_WAIT_V(6); PG8_BAR;
    } else {
        PG8_STAGE(PG8_SB(0, 0), cB, voffB); PG8_STAGE(PG8_SA(0, 0), cA, voffA); PG8_STAGE(PG8_SB(0, 1), cB + hstep, voffB); PG8_STAGE(PG8_SA(0, 1), cA + hstep, voffA);
        if (wr == 1) PG8_BAR;
        PG8_WAIT_V(4); PG8_BAR;
        PG8_STAGE(PG8_SB(1, 0), cB + kstep, voffB); PG8_STAGE(PG8_SA(1, 0), cA + kstep, voffA); PG8_STAGE(PG8_SB(1, 1), cB + hstep + kstep, voffB);
        PG8_WAIT_V(6); PG8_BAR;
    }
    for (;;) {
        const bool has_next = S.next(ui + 1, nxt);
        const char* nA = has_next ? (const char*)g.A + (size_t)nxt.pm * tstep : cA; const char* nB = has_next ? (const char*)g.Bt + (size_t)nxt.pn * tstep : cB;
        for (int t = 0; t < nt; t += 2) {
            const bool last = (t == nt - 2);
            const char* a1 = cA + (size_t)(t + 1) * kstep;
            const char* a2 = last ? nA : cA + (size_t)(t + 2) * kstep; const char* b2 = last ? nB : cB + (size_t)(t + 2) * kstep;
            const char* a3 = a2 + kstep; const char* b3 = b2 + kstep;
            if (last && has_next) S.a_ready(nxt);
            if constexpr (SP2) {
            PG8_LDB(B0, 0, 0); PG8_LDB(B1, 0, 1); PG8_SCHED; PG8_LDA(At, 0, 0); PG8_STAGE(PG8_SA(1, 1), a1 + hstep, voffA);
            PG8_WAIT_V(8); PG8_WAIT_L(0); PG8_BAR; PG8_MMA(0, 0, At, B0); PG8_MMA(0, 1, At, B1); PG8_BAR; PG8_SCHED;
            PG8_LDA(At, 0, 1); PG8_STAGE(PG8_SB(0, 0), b2, voffB); PG8_STAGE(PG8_SB(0, 1), b2 + hstep, voffB); PG8_STAGE(PG8_SA(0, 0), a2, voffA);
            PG8_WAIT_V(8); PG8_WAIT_L(0); PG8_BAR; PG8_MMA(1, 0, At, B0); PG8_MMA(1, 1, At, B1); PG8_BAR; PG8_SCHED;
            PG8_LDB(B0, 1, 0); PG8_LDB(B1, 1, 1); PG8_SCHED; PG8_LDA(At, 1, 0); PG8_STAGE(PG8_SA(0, 1), a2 + hstep, voffA);
            PG8_WAIT_V(8); PG8_WAIT_L(0); PG8_BAR; PG8_MMA(0, 0, At, B0); PG8_MMA(0, 1, At, B1); PG8_BAR; PG8_SCHED;
            PG8_LDA(At, 1, 1); PG8_STAGE(PG8_SB(1, 0), b3, voffB); PG8_STAGE(PG8_SB(1, 1), b3 + hstep, voffB); PG8_STAGE(PG8_SA(1, 0), a3, voffA);
            PG8_WAIT_V(8); PG8_WAIT_L(0); PG8_BAR; PG8_MMA(1, 0, At, B0); PG8_MMA(1, 1, At, B1); PG8_BAR; PG8_SCHED;
            } else {
            PG8_LDB(B0, 0, 0); PG8_SCHED; PG8_LDA(At, 0, 0); PG8_STAGE(PG8_SA(1, 1), a1 + hstep, voffA);
            PG8_WAIT_L(8); PG8_BAR; PG8_WAIT_L(0); PG8_MMA(0, 0, At, B0); PG8_BAR; PG8_SCHED;
            PG8_LDB(B1, 0, 1); PG8_STAGE(PG8_SB(0, 0), b2, voffB);
            PG8_BAR; PG8_WAIT_L(0); PG8_MMA(0, 1, At, B1); PG8_BAR;
            PG8_LDA(At, 0, 1); PG8_STAGE(PG8_SA(0, 0), a2, voffA);
            PG8_BAR; PG8_WAIT_L(0); PG8_MMA(1, 0, At, B0); PG8_BAR; PG8_SCHED;
            PG8_STAGE(PG8_SB(0, 1), b2 + hstep, voffB);
            PG8_WAIT_V(6); PG8_BAR; PG8_MMA(1, 1, At, B1); PG8_BAR;
            PG8_LDB(B0, 1, 0); PG8_SCHED; PG8_LDA(At, 1, 0); PG8_STAGE(PG8_SA(0, 1), a2 + hstep, voffA);
            PG8_WAIT_L(8); PG8_BAR; PG8_WAIT_L(0); PG8_MMA(0, 0, At, B0); PG8_BAR; PG8_SCHED;
            PG8_LDB(B1, 1, 1); PG8_STAGE(PG8_SB(1, 0), b3, voffB);
            PG8_BAR; PG8_WAIT_L(0); PG8_MMA(0, 1, At, B1); PG8_BAR;
            PG8_LDA(At, 1, 1); PG8_STAGE(PG8_SA(1, 0), a3, voffA);
            PG8_BAR; PG8_WAIT_L(0); PG8_MMA(1, 0, At, B0); PG8_BAR; PG8_SCHED;
            PG8_STAGE(PG8_SB(1, 1), b3 + hstep, voffB);
            PG8_WAIT_V(6); PG8_BAR; PG8_MMA(1, 1, At, B1); PG8_BAR;
            }
        }
        if constexpr (ALIGN_EPI) { if (wr == 0) PG8_BAR; }
        if constexpr (!Epi::AFTER_DRAIN) { E(acc, cur, wr, wc, fr, fq); S.done(cur); }
        if (!has_next) break;
#pragma unroll
        for (int a = 0; a < 2; ++a)
#pragma unroll
            for (int b = 0; b < 2; ++b)
#pragma unroll
                for (int m = 0; m < 4; ++m)
#pragma unroll
                    for (int n = 0; n < 2; ++n) acc[a][b][m][n] = (f32x4){0.f, 0.f, 0.f, 0.f};
        cur = nxt; cA = nA; cB = nB; ++ui;
        if constexpr (ALIGN_EPI) { if (wr == 1) PG8_BAR; }
    }
    PG8_WAIT_V(0);
    if constexpr (!ALIGN_EPI) { if (wr == 0) PG8_BAR; }
    PG8_BAR;
    if constexpr (Epi::AFTER_DRAIN) { E.fused(acc, cur, wr, wc, fr, fq, lds, wid, lane); S.done(cur); }
#undef PG8_SA
#undef PG8_SB
#undef PG8_STAGE
#undef PG8_LDA
#undef PG8_LDB
#undef PG8_MMA
#undef PG8_WAIT_V
#undef PG8_WAIT_L
#undef PG8_BAR
#undef PG8_SCHED
}
}

#define LAS __attribute__((address_space(3)))
typedef unsigned short bf16;
typedef unsigned v4u __attribute__((ext_vector_type(4)));
typedef unsigned v2u __attribute__((ext_vector_type(2)));
typedef float f32x4 __attribute__((ext_vector_type(4)));
typedef float f32x2 __attribute__((ext_vector_type(2)));
typedef float f32x16 __attribute__((ext_vector_type(16)));
typedef short bf16x8 __attribute__((ext_vector_type(8)));
typedef short s16x4 __attribute__((ext_vector_type(4)));

constexpr int DM = 1024, SEQ = 4096, CTXL = 256, NBATCH = 4, MLAT = 16384, MTOT = 17408, INW = 2048, DFF = 4096, NLAYER = 4, NADA = 6144;
constexpr size_t MiB = 1u << 20;
constexpr size_t WS_BAR = 512 * 1024, WS_BAR_BYTES = 16384;
constexpr size_t WS_ADA = 0, WS_ROPE = 1 * MiB, WS_W = 2 * MiB, W_LAYER = 23 * MiB;
constexpr size_t WO_IN = 0, WO_OUT = 4 * MiB, WO_1 = 6 * MiB, WO_2 = 14 * MiB, WO_P = 22 * MiB;
constexpr size_t WS_X = 94 * MiB, WS_H = 162 * MiB, WS_Z = 196 * MiB, WS_MIX = 264 * MiB, WS_A = 196 * MiB, WS_PART = 332 * MiB, WS_END = 348 * MiB;
constexpr int LDS_BYTES = 147456, LDS_CTL = 143360;
constexpr int NWAVES = 8;

struct Params {
    const float *x, *c, *ctx, *c_ctx, *w_ada, *b_ada, *g_mix, *g_mlp, *w_in, *w_pool, *s_pool, *lq1, *lk1, *lq2, *lk2, *g_sub, *w_out, *w1, *w2, *g_final;
    float* out; unsigned char* ws;
};

__device__ __forceinline__ unsigned f2bf(float f) { unsigned u = __builtin_bit_cast(unsigned, f); return (u + 0x7fffu + ((u >> 16) & 1u)) >> 16; }
__device__ __forceinline__ unsigned pk2(float lo, float hi) { return f2bf(lo) | (f2bf(hi) << 16); }
__device__ __forceinline__ float bf2f(unsigned short v) { return __builtin_bit_cast(float, (unsigned)v << 16); }
__device__ __forceinline__ float shfl_xor_l(float v, int mask, int lane) { return __builtin_bit_cast(float, __builtin_amdgcn_ds_bpermute((lane ^ mask) << 2, __builtin_bit_cast(int, v))); }
__device__ __forceinline__ float wave_sum(float v, int lane) {
#pragma unroll
    for (int o = 1; o < 64; o <<= 1) v += shfl_xor_l(v, o, lane);
    return v;
}

__device__ __forceinline__ int inproj_dest(int n) { if (n < 512 || n >= 1536) return n; const int p = n & 63, nb = n - p; return nb + 2 * (p & 31) + (p >> 5); }
template <bool PERMQK>
__device__ __forceinline__ void transpose_item(const float* W, int K, int N, bf16* WT, LAS float* scr, int item, int lane) {
    const int nblk = N / 32, kb = item / nblk, nb = item % nblk, k0 = 64 * kb, n0 = 32 * nb;
    { const int kr = lane >> 3, c4 = lane & 7;
      f32x4 tv[8];
#pragma unroll
      for (int i = 0; i < 8; ++i) tv[i] = *(const f32x4*)(W + (size_t)(k0 + 8 * i + kr) * N + n0 + 4 * c4);
#pragma unroll
      for (int i = 0; i < 8; ++i) { LAS float* d = scr + (8 * i + kr) * 33 + 4 * c4; d[0] = tv[i].x; d[1] = tv[i].y; d[2] = tv[i].z; d[3] = tv[i].w; } }
    asm volatile("s_waitcnt lgkmcnt(0)" ::: "memory");
    const int c = lane & 7;
#pragma unroll
    for (int j = 0; j < 4; ++j) { const int n = (lane >> 3) + 8 * j; const LAS float* s = scr + (8 * c) * 33 + n;
        v4u o; o.x = pk2(s[0 * 33], s[1 * 33]); o.y = pk2(s[2 * 33], s[3 * 33]); o.z = pk2(s[4 * 33], s[5 * 33]); o.w = pk2(s[6 * 33], s[7 * 33]);
        const int nd = PERMQK ? inproj_dest(n0 + n) : (n0 + n);
        *(v4u*)(WT + (size_t)nd * K + k0 + 8 * c) = o; }
    asm volatile("s_waitcnt lgkmcnt(0)" ::: "memory");
}

__device__ __forceinline__ void prologue(const Params& p, LAS unsigned char* lds, int tid, int lane, int wid) {
    const int G = gridDim.x, bx = blockIdx.x;
    float* ada = (float*)(p.ws + WS_ADA);
    if (bx < 192) {
        LAS float* S = (LAS float*)lds;
        LAS float* P = (LAS float*)(lds + 20480);
        for (int idx = tid; idx < 5 * 1024; idx += 512) { const int r = idx >> 10, k = idx & 1023; const float v = (r < 4) ? p.c[r * 1024 + k] : p.c_ctx[k]; S[idx] = v / (1.f + __expf(-v)); }
        __syncthreads();
        for (int it = bx; it < 192; it += G) {
            const int l = it / 48, j0 = (it % 48) * 128;
            const float* wp = p.w_ada + ((size_t)l * 1024 + wid * 128) * NADA + j0 + 2 * lane;
            f32x2 a0 = {0.f, 0.f}, a1 = a0, a2 = a0, a3 = a0, a4 = a0;
#pragma unroll 16
            for (int k = 0; k < 128; ++k) { const f32x2 w = *(const f32x2*)(wp + (size_t)k * NADA); const int kk = wid * 128 + k;
                a0 += w * S[kk]; a1 += w * S[1024 + kk]; a2 += w * S[2048 + kk]; a3 += w * S[3072 + kk]; a4 += w * S[4096 + kk]; }
            LAS float* pw = P + wid * 640 + 2 * lane;
            *(LAS f32x2*)(pw) = a0; *(LAS f32x2*)(pw + 128) = a1; *(LAS f32x2*)(pw + 256) = a2; *(LAS f32x2*)(pw + 384) = a3; *(LAS f32x2*)(pw + 512) = a4;
            __syncthreads();
            for (int o = tid; o < 640; o += 512) { const int r = o >> 7, j = o & 127; float s = p.b_ada[l * NADA + j0 + j];
#pragma unroll
                for (int w = 0; w < 8; ++w) s += P[w * 640 + o];
                ada[((size_t)l * 5 + r) * NADA + j0 + j] = s; }
            __syncthreads();
        }
    }
    __syncthreads();
    {
        float* cosT = (float*)(p.ws + WS_ROPE); float* sinT = cosT + 4096 * 32;
        for (int idx = bx * 512 + tid; idx < 4096 * 32; idx += G * 512) { const int t = idx >> 5, i = idx & 31;
            const float inv = exp2f(-(float)(i & 15) * (13.287712379549449f / 16.0f));
            const float ang = (float)((i < 16) ? (t >> 6) : (t & 63)) * inv;
            cosT[idx] = __cosf(ang); sinT[idx] = __sinf(ang); }
    }
    {
        LAS float* scr = (LAS float*)(lds + wid * 16384);
        const int gw = bx * NWAVES + wid, NGW = G * NWAVES;
        constexpr int I_IN = 16 * 64, I_OUT = 16 * 32, I_1 = 16 * 128, I_2 = 64 * 32, I_P = 4 * 8, I_L = I_IN + I_OUT + I_1 + I_2 + I_P;
        for (int it = gw; it < NLAYER * I_L; it += NGW) {
            const int l = it / I_L; int r = it % I_L;
            unsigned char* wl = p.ws + WS_W + (size_t)l * W_LAYER;
            if (r < I_IN) { transpose_item<true>(p.w_in + (size_t)l * DM * INW, DM, INW, (bf16*)(wl + WO_IN), scr, r, lane); continue; } r -= I_IN;
            if (r < I_OUT) { transpose_item<false>(p.w_out + (size_t)l * DM * DM, DM, DM, (bf16*)(wl + WO_OUT), scr, r, lane); continue; } r -= I_OUT;
            if (r < I_1) { transpose_item<false>(p.w1 + (size_t)l * DM * DFF, DM, DFF, (bf16*)(wl + WO_1), scr, r, lane); continue; } r -= I_1;
            if (r < I_2) { transpose_item<false>(p.w2 + (size_t)l * DFF * DM, DFF, DM, (bf16*)(wl + WO_2), scr, r, lane); continue; } r -= I_2;
            { const int g = r >> 3; transpose_item<false>(p.w_pool + ((size_t)l * 4 + g) * 128 * 128, 128, 128, (bf16*)(wl + WO_P) + g * 16384, scr, r & 7, lane); }
        }
    }
}

#define NORM_ROWS_BEGIN() const int gw = blockIdx.x * NWAVES + wid, NGW = gridDim.x * NWAVES; \
    int q_ = 0; while ((q_ + 1) * NGW <= nrows) ++q_;                         \
    const int rem_ = nrows - q_ * NGW, r0 = gw * q_ + (gw < rem_ ? gw : rem_), r1 = r0 + q_ + (gw < rem_ ? 1 : 0)
#define NORM_LOAD_MOD(b_) do { const f32x4* gp_ = (const f32x4*)g + lane; const f32x4* sh_ = (const f32x4*)(adal + (size_t)(b_) * NADA + shift_idx * DM) + lane; \
        const f32x4* sc_ = (const f32x4*)(adal + (size_t)(b_) * NADA + (shift_idx + 1) * DM) + lane; \
        _Pragma("unroll") for (int j = 0; j < 4; ++j) { Gm[j] = gp_[64 * j] * (sc_[64 * j] + 1.0f); Sh[j] = sh_[64 * j]; } } while (0)
__device__ __forceinline__ void norm_mod_phase(const float* src_lat, const float* src_ctx, const float* g, const float* adal, int shift_idx, bf16* H, int nrows, int lane, int wid) {
    NORM_ROWS_BEGIN();
    int bcur = -1; f32x4 Gm[4], Sh[4];
    for (int row = r0; row < r1; ++row) {
        const bool lat = row < MLAT; const int b = lat ? (row >> 12) : 4;
        if (b != bcur) { NORM_LOAD_MOD(b); bcur = b; }
        const f32x4* xr = (const f32x4*)(lat ? src_lat + (size_t)row * DM : src_ctx + (size_t)(row - MLAT) * DM) + lane;
        f32x4 v[4]; float s = 0.f;
#pragma unroll
        for (int j = 0; j < 4; ++j) { v[j] = xr[64 * j]; s += (v[j].x * v[j].x + v[j].y * v[j].y) + (v[j].z * v[j].z + v[j].w * v[j].w); }
        const float rinv = 1.0f / sqrtf(wave_sum(s, lane) * (1.f / DM) + 1e-6f);
        unsigned long long* o8 = (unsigned long long*)(H + (size_t)row * DM) + lane;
#pragma unroll
        for (int j = 0; j < 4; ++j) { const f32x4 y = v[j] * rinv * Gm[j] + Sh[j];
            o8[64 * j] = (unsigned long long)pk2(y.x, y.y) | ((unsigned long long)pk2(y.z, y.w) << 32); }
    }
}
__device__ __forceinline__ f32x4 unpack4(v2u q) { return (f32x4){__builtin_bit_cast(float, q.x << 16), __builtin_bit_cast(float, q.x & 0xffff0000u), __builtin_bit_cast(float, q.y << 16), __builtin_bit_cast(float, q.y & 0xffff0000u)}; }
__device__ __forceinline__ void norm_mod_phase16(bf16* X16, const float* g, const float* adal, int shift_idx, bf16* H, int nrows, int lane, int wid, const float* part = nullptr, const float* pgate = nullptr) {
    NORM_ROWS_BEGIN();
    int bcur = -1; f32x4 Gm[4], Sh[4];
    for (int row = r0; row < r1; ++row) {
        const int b = row < MLAT ? (row >> 12) : 4;
        if (b != bcur) { NORM_LOAD_MOD(b); bcur = b; }
        const v2u* xr = (const v2u*)(X16 + (size_t)row * DM) + lane;
        f32x4 v[4]; float s = 0.f;
#pragma unroll
        for (int j = 0; j < 4; ++j) v[j] = unpack4(xr[64 * j]);
        if (part != nullptr && row >= MLAT) {
            const f32x4* pp = (const f32x4*)(part + (size_t)(row - MLAT) * DM) + lane; const f32x4* pg = (const f32x4*)pgate + lane;
#pragma unroll
            for (int j = 0; j < 4; ++j) { const f32x4 t = (pp[64 * j] + pp[64 * j + 262144]) + (pp[64 * j + 2 * 262144] + pp[64 * j + 3 * 262144]);
                v[j] += pg[64 * j] * t;
                v2u w; w.x = pk2(v[j].x, v[j].y); w.y = pk2(v[j].z, v[j].w); ((v2u*)(X16 + (size_t)row * DM) + lane)[64 * j] = w;
                v[j] = unpack4(w); }
        }
#pragma unroll
        for (int j = 0; j < 4; ++j) s += (v[j].x * v[j].x + v[j].y * v[j].y) + (v[j].z * v[j].z + v[j].w * v[j].w);
        const float rinv = 1.0f / sqrtf(wave_sum(s, lane) * (1.f / DM) + 1e-6f);
        unsigned long long* o8 = (unsigned long long*)(H + (size_t)row * DM) + lane;
#pragma unroll
        for (int j = 0; j < 4; ++j) { const f32x4 y = v[j] * rinv * Gm[j] + Sh[j];
            o8[64 * j] = (unsigned long long)pk2(y.x, y.y) | ((unsigned long long)pk2(y.z, y.w) << 32); }
    }
}
__device__ __forceinline__ void final_norm_phase(const bf16* X16, const float* g, float* out, int lane, int wid) {
    const int nrows = MLAT;
    NORM_ROWS_BEGIN();
    f32x4 Gm[4];
    { const f32x4* gp = (const f32x4*)g + lane;
#pragma unroll
      for (int j = 0; j < 4; ++j) Gm[j] = gp[64 * j]; }
    for (int row = r0; row < r1; ++row) {
        const v2u* xr = (const v2u*)(X16 + (size_t)row * DM) + lane;
        f32x4 v[4]; float s = 0.f;
#pragma unroll
        for (int j = 0; j < 4; ++j) { v[j] = unpack4(xr[64 * j]); s += (v[j].x * v[j].x + v[j].y * v[j].y) + (v[j].z * v[j].z + v[j].w * v[j].w); }
        const float rinv = 1.0f / sqrtf(wave_sum(s, lane) * (1.f / DM) + 1e-6f);
        f32x4* o = (f32x4*)(out + (size_t)row * DM) + lane;
#pragma unroll
        for (int j = 0; j < 4; ++j) o[64 * j] = v[j] * rinv * Gm[j];
    }
}
#undef NORM_ROWS_BEGIN
#undef NORM_LOAD_MOD

constexpr int POOL_PITCH = 1040;
__device__ __forceinline__ void pool_unit(LAS unsigned char* lds, const bf16* Z, bf16* MIX, const bf16* WpT, const float* spool, int tt, int tid, int lane, int wid) {
    const int row0 = tt * 64;
    int seq0, n; if (row0 < MLAT) { seq0 = row0 & ~4095; n = SEQ; } else { seq0 = MLAT + ((row0 - MLAT) & ~255); n = CTXL; }
    const int t0 = row0 - seq0;
    v4u uv[10];
#pragma unroll
    for (int i = 0; i < 10; ++i) { const int r = wid + 8 * i, tok = t0 - 8 + r; uv[i] = (v4u){0u, 0u, 0u, 0u};
        if (r < 79 && tok >= 0 && tok < n) uv[i] = *(const v4u*)(Z + (size_t)(seq0 + tok) * INW + lane * 8); }
    const int g = wid >> 1, dbase = (wid & 1) * 64, fr = lane & 15, fq = lane >> 4;
    bf16x8 af[4][4];
    { const bf16* Wg = WpT + g * 16384;
#pragma unroll
      for (int kk = 0; kk < 4; ++kk)
#pragma unroll
          for (int mi = 0; mi < 4; ++mi) af[kk][mi] = *(const bf16x8*)(Wg + (dbase + 16 * mi + fr) * 128 + 32 * kk + 8 * fq); }
#pragma unroll
    for (int i = 0; i < 10; ++i) { const int r = wid + 8 * i; if (r < 79) *(LAS v4u*)(lds + r * POOL_PITCH + lane * 16) = uv[i]; }
    __syncthreads();
    {
        const int cq = tid & 127, tq = tid >> 7, gg = cq >> 5, w = 2 << gg, lo = w >> 1, hiw = (w >> 1) - 1;
        LAS v2u* colw = (LAS v2u*)lds + cq;
        constexpr int RW = POOL_PITCH / 8;
        const int ts = 16 * tq;
        f32x4 sm = (f32x4){0.f, 0.f, 0.f, 0.f};
        for (int r = ts + 8 - lo; r <= ts + 8 + hiw; ++r) sm += unpack4(colw[r * RW]);
        for (int i = 0; i < 16; ++i) { const int t = ts + i;
            const int tok = t0 + t; const int a = max(tok - lo, 0), e = min(tok + hiw, n - 1);
            const float rc = 1.0f / (float)(e - a + 1);
            const f32x4 uo = unpack4(colw[(t + 8 - lo) * RW]), ui = unpack4(colw[(t + 8) * RW]);
            const f32x4 y = sm * rc - ui;
            v2u wv; wv.x = pk2(y.x, y.y); wv.y = pk2(y.z, y.w);
            colw[(tq ? 63 + t : t) * RW] = wv;
            if (i < 15) sm += unpack4(colw[(t + 9 + hiw) * RW]) - uo;
        }
    }
    __syncthreads();
    {
        f32x4 acc[4][4];
#pragma unroll
        for (int a = 0; a < 4; ++a)
#pragma unroll
            for (int b = 0; b < 4; ++b) acc[a][b] = (f32x4){0.f, 0.f, 0.f, 0.f};
#pragma unroll
        for (int kk = 0; kk < 4; ++kk) {
            bf16x8 bfr[4];
#pragma unroll
            for (int ni = 0; ni < 4; ++ni) { const int rowi = (ni < 1) ? fr : 63 + 16 * ni + fr;
                bfr[ni] = *(const LAS bf16x8*)(lds + rowi * POOL_PITCH + (128 * g + 32 * kk + 8 * fq) * 2); }
#pragma unroll
            for (int mi = 0; mi < 4; ++mi)
#pragma unroll
                for (int ni = 0; ni < 4; ++ni) acc[mi][ni] = __builtin_amdgcn_mfma_f32_16x16x32_bf16(af[kk][mi], bfr[ni], acc[mi][ni], 0, 0, 0);
        }
#pragma unroll
        for (int mi = 0; mi < 4; ++mi) { const int d0 = dbase + 16 * mi + 4 * fq; const f32x4 sp = *(const f32x4*)(spool + 128 * g + d0);
#pragma unroll
            for (int ni = 0; ni < 4; ++ni) { const int t = 16 * ni + fr; const f32x4 v = acc[mi][ni] * sp;
                v2u w; w.x = pk2(v.x, v.y); w.y = pk2(v.z, v.w);
                *(v2u*)(MIX + (size_t)(row0 + t) * DM + 128 * g + d0) = w; } }
    }
    __syncthreads();
}

namespace att {
constexpr int BUF = 32768, K1_OFF = 0, K2_OFF = 8192, V_OFF = 16384, SCR_OFF = 4 * 32768;
__device__ __forceinline__ void glds16(const void* gsrc, unsigned lds_dst) { unsigned keep;
    asm volatile("s_mov_b32 %0, m0\n\ts_mov_b32 m0, %2\n\ts_nop 0\n\tglobal_load_lds_dwordx4 %1, off\n\ts_mov_b32 m0, %0" : "=&s"(keep) : "v"(gsrc), "s"(lds_dst) : "memory"); }
typedef short v4i16_t __attribute__((ext_vector_type(4)));
__device__ __forceinline__ int crow(int r, int hi) { return (r & 3) + 8 * (r >> 2) + 4 * hi; }
__device__ __forceinline__ bf16x8 pack8(const f32x16& x, int s) {
    typedef __bf16 bf16x2_t __attribute__((ext_vector_type(2)));
    v4u p;
#pragma unroll
    for (int j = 0; j < 4; ++j) { f32x2 v = {x[8 * s + 2 * j], x[8 * s + 2 * j + 1]}; bf16x2_t b = __builtin_convertvector(v, bf16x2_t); p[j] = __builtin_bit_cast(unsigned, b); }
    return __builtin_bit_cast(bf16x8, p);
}
__device__ __forceinline__ int tile_row(bool latent, int b, int t) { return latent ? (t < 4 ? MLAT + b * CTXL + 64 * t : b * SEQ + 64 * (t - 4)) : (MLAT + b * CTXL + 64 * t); }

__device__ __forceinline__ void attn_unit(LAS unsigned char* lds, const bf16* Z, bf16* MIX, int b, int h, int qrow0, int NT, bool latent, float lam, float oscale, const float* gsub, int tid, int lane, int wid) {
    const int r32 = lane & 31, hi = lane >> 5, qg = wid >> 1, s = wid & 1;
    const unsigned lds0 = (unsigned)(uintptr_t)lds;
    const int kkey = 8 * wid + (lane >> 3), kcs = (lane & 7) ^ ((kkey >> 1) & 7);
    const int ksrc = kkey * INW + 1024 + (2 * h) * 64 + kcs * 8;
    const int pc0 = wid, pc1 = wid + 8;
    const int vsrc0 = (16 * (pc0 & 3) + (lane >> 2)) * INW + 1536 + h * 128 + (pc0 >> 2) * 32 + (lane & 3) * 8;
    const int vsrc1 = (16 * (pc1 & 3) + (lane >> 2)) * INW + 1536 + h * 128 + (pc1 >> 2) * 32 + (lane & 3) * 8;
#define ATT_DMA(t, bo_) do { const bf16* base_ = Z + (size_t)tile_row(latent, b, (t)) * INW; const unsigned d_ = lds0 + (unsigned)(bo_); \
        glds16(base_ + ksrc, (unsigned)__builtin_amdgcn_readfirstlane(d_ + K1_OFF + wid * 1024)); glds16(base_ + ksrc + 64, (unsigned)__builtin_amdgcn_readfirstlane(d_ + K2_OFF + wid * 1024)); \
        glds16(base_ + vsrc0, (unsigned)__builtin_amdgcn_readfirstlane(d_ + V_OFF + pc0 * 1024)); glds16(base_ + vsrc1, (unsigned)__builtin_amdgcn_readfirstlane(d_ + V_OFF + pc1 * 1024)); } while (0)
#define ATT_WAIT_BAR(N) asm volatile("s_waitcnt vmcnt(" #N ") lgkmcnt(0)\n\ts_barrier" ::: "memory")
    ATT_DMA(0, 0); ATT_DMA(1, BUF); ATT_DMA(2, 2 * BUF);
    bf16x8 qr[4];
    { const bf16* Qp = Z + (size_t)(qrow0 + qg * 32 + r32) * INW + 512 + (2 * h + s) * 64 + hi * 8;
#pragma unroll
      for (int d0 = 0; d0 < 4; ++d0) qr[d0] = *(const bf16x8*)(Qp + d0 * 16); }
    asm volatile("" : "+v"(qr[0]), "+v"(qr[1]), "+v"(qr[2]), "+v"(qr[3]));
    ATT_WAIT_BAR(0);
    float m = 0.f, l = 0.f;
    f32x16 o[4];
#pragma unroll
    for (int d0 = 0; d0 < 4; ++d0)
#pragma unroll
        for (int i = 0; i < 16; ++i) o[d0][i] = 0.f;
    LAS float* scr = (LAS float*)(lds + SCR_OFF) + wid * 64;
    const int kbase = s ? K2_OFF : K1_OFF;
    const int vlane = (4 * hi + ((lane & 15) >> 2)) * 64 + ((lane >> 4) & 1) * 32 + (lane & 3) * 8;
    const int klane = kbase + r32 * 128;
    const int ksw = (r32 >> 1) & 7;
#define ATT_TR(p_) __builtin_bit_cast(s16x4, __builtin_amdgcn_ds_read_tr16_b64_v4i16((LAS v4i16_t*)(p_)))
#define ATT_VF(a_, i_) ((bf16x8){a_[2 * (i_)][0], a_[2 * (i_)][1], a_[2 * (i_)][2], a_[2 * (i_)][3], a_[2 * (i_) + 1][0], a_[2 * (i_) + 1][1], a_[2 * (i_) + 1][2], a_[2 * (i_) + 1][3]})
#define ATT_KLOAD(bo_) do { _Pragma("unroll") for (int d0 = 0; d0 < 4; ++d0) { const LAS unsigned char* ka = lds + (bo_) + klane + (((2 * d0 + hi) ^ ksw) * 16); \
            kf[2 * d0] = *(const LAS bf16x8*)ka; kf[2 * d0 + 1] = *(const LAS bf16x8*)(ka + 4096); } } while (0)
#define ATT_VLOAD(dst_, ks_) do { _Pragma("unroll") for (int d0 = 0; d0 < 4; ++d0) { const LAS unsigned char* vp = lds + bo + V_OFF + d0 * 4096 + (ks_) * 1024 + vlane; \
            dst_[d0 * 2] = ATT_TR(vp); dst_[d0 * 2 + 1] = ATT_TR(vp + 512); } } while (0)
#define ATT_PV(src_, ks_) do { _Pragma("unroll") for (int d0 = 0; d0 < 4; ++d0) o[d0] = __builtin_amdgcn_mfma_f32_32x32x16_bf16(pa[ks_], ATT_VF(src_, d0), o[d0], 0, 0, 0); } while (0)
#define ATT_QK(P0_, P1_) do { _Pragma("unroll") for (int i = 0; i < 16; ++i) { P0_[i] = 0.f; P1_[i] = 0.f; } \
        _Pragma("unroll") for (int d0 = 0; d0 < 4; ++d0) { P0_ = __builtin_amdgcn_mfma_f32_32x32x16_bf16(kf[2 * d0], qr[d0], P0_, 0, 0, 0); P1_ = __builtin_amdgcn_mfma_f32_32x32x16_bf16(kf[2 * d0 + 1], qr[d0], P1_, 0, 0, 0); } } while (0)
    f32x16 p0, p1;
#define ATT_ROWMAX(P0_, P1_, OUT_) do { float rm_ = fmaxf(P0_[0], P1_[0]); _Pragma("unroll") for (int i = 1; i < 16; ++i) rm_ = fmaxf(rm_, fmaxf(P0_[i], P1_[i])); OUT_ = fmaxf(rm_, shfl_xor_l(rm_, 32, lane)); } while (0)
    { bf16x8 kf[8]; ATT_KLOAD(0); ATT_QK(p0, p1); }
    float rm; ATT_ROWMAX(p0, p1, rm);
    int bo = 0, bo1 = BUF, bo2 = 2 * BUF, bo3 = 3 * BUF;
    for (int t = 0; t < NT; ++t) {
        if (t + 3 < NT) ATT_DMA(t + 3, bo3);
        bf16x8 kf[8]; ATT_KLOAD(bo1);
        s16x4 va[8], vb[8];
        ATT_VLOAD(va, 0);
        __builtin_amdgcn_sched_barrier(0);
        const bool first = (t == 0);
        if (first || __any(rm > 8.0f)) {
            const float dl = first ? rm : fmaxf(rm, 0.f);
            const float al = __builtin_amdgcn_exp2f(-dl);
            m += dl; l *= al;
#pragma unroll
            for (int i = 0; i < 16; ++i) { p0[i] -= dl; p1[i] -= dl; }
            if (hi == 0) scr[r32] = al;
            __builtin_amdgcn_wave_barrier();
#pragma unroll
            for (int i = 0; i < 16; ++i) { const float a = scr[crow(i, hi)];
#pragma unroll
                for (int d0 = 0; d0 < 4; ++d0) o[d0][i] *= a; }
            __builtin_amdgcn_wave_barrier();
        }
        __builtin_amdgcn_sched_barrier(0);
        f32x16 n0, n1;
        ATT_QK(n0, n1);
        f32x2 sacc = {0.f, 0.f};
#pragma unroll
        for (int i = 0; i < 16; i += 2) { p0[i] = __builtin_amdgcn_exp2f(p0[i]); p0[i + 1] = __builtin_amdgcn_exp2f(p0[i + 1]); sacc += (f32x2){p0[i], p0[i + 1]}; }
        bf16x8 pa[4]; pa[0] = pack8(p0, 0); pa[1] = pack8(p0, 1);
        __builtin_amdgcn_sched_barrier(0);
        ATT_VLOAD(vb, 1);
        ATT_PV(va, 0);
#pragma unroll
        for (int i = 0; i < 16; i += 2) { p1[i] = __builtin_amdgcn_exp2f(p1[i]); p1[i + 1] = __builtin_amdgcn_exp2f(p1[i + 1]); sacc += (f32x2){p1[i], p1[i + 1]}; }
        pa[2] = pack8(p1, 0); pa[3] = pack8(p1, 1);
        l += sacc.x + sacc.y;
        __builtin_amdgcn_sched_barrier(0);
        ATT_VLOAD(va, 2);
        __builtin_amdgcn_sched_barrier(0);
        ATT_PV(vb, 1);
        __builtin_amdgcn_sched_barrier(0);
        ATT_VLOAD(vb, 3);
        __builtin_amdgcn_sched_barrier(0);
        ATT_PV(va, 2);
        { const f32x2 nm2 = {-m, -m};
          _Pragma("unroll") for (int i = 0; i < 16; i += 2) { f32x2 a = {n0[i], n0[i + 1]}, c2 = {n1[i], n1[i + 1]}; a += nm2; c2 += nm2; n0[i] = a.x; n0[i + 1] = a.y; n1[i] = c2.x; n1[i + 1] = c2.y; } }
        ATT_PV(vb, 3);
        ATT_ROWMAX(n0, n1, rm);
        if (t + 3 < NT) ATT_WAIT_BAR(4); else ATT_WAIT_BAR(0);
        p0 = n0; p1 = n1;
        { const int tmp_ = bo; bo = bo1; bo1 = bo2; bo2 = bo3; bo3 = tmp_; }
    }
#undef ATT_ROWMAX
#undef ATT_KLOAD
#undef ATT_VLOAD
#undef ATT_PV
#undef ATT_QK
#undef ATT_TR
#undef ATT_VF
#undef ATT_DMA
#undef ATT_WAIT_BAR
    l += shfl_xor_l(l, 32, lane);
    if (hi == 0) scr[32 + r32] = 1.0f / l;
    __builtin_amdgcn_wave_barrier();
#pragma unroll
    for (int i = 0; i < 16; ++i) { const float a = scr[32 + crow(i, hi)];
#pragma unroll
        for (int d0 = 0; d0 < 4; ++d0) o[d0][i] *= a; }
    LAS float* ex = (LAS float*)lds + qg * 4096 + lane;
    if (s == 1) {
#pragma unroll
        for (int d0 = 0; d0 < 4; ++d0)
#pragma unroll
            for (int i = 0; i < 16; ++i) ex[(d0 * 16 + i) * 64] = o[d0][i];
    }
    __syncthreads();
    if (s == 0) {
        float ssq[16];
#pragma unroll
        for (int i = 0; i < 16; ++i) { float q = 0.f;
#pragma unroll
            for (int d0 = 0; d0 < 4; ++d0) { const float v = o[d0][i] - lam * ex[(d0 * 16 + i) * 64]; o[d0][i] = v; q += v * v; }
            ssq[i] = q; }
#define ATT_DPP_ROR(v_, n_) __builtin_bit_cast(float, __builtin_amdgcn_update_dpp(0, __builtin_bit_cast(int, (v_)), 0x120 + (n_), 0xf, 0xf, false))
#pragma unroll
        for (int i = 0; i < 16; ++i) { float v = ssq[i];
            v += ATT_DPP_ROR(v, 8); v += ATT_DPP_ROR(v, 4); v += ATT_DPP_ROR(v, 2); v += ATT_DPP_ROR(v, 1);
            ssq[i] = v + shfl_xor_l(v, 16, lane); }
#undef ATT_DPP_ROR
        float gs[4];
#pragma unroll
        for (int d0 = 0; d0 < 4; ++d0) gs[d0] = gsub[32 * d0 + r32] * oscale;
#pragma unroll
        for (int i = 0; i < 16; ++i) { const float rn = 1.0f / sqrtf(ssq[i] * (1.0f / 128.0f) + 1e-6f);
            bf16* op = MIX + (size_t)(qrow0 + qg * 32 + crow(i, hi)) * DM + 512 + h * 128 + r32;
#pragma unroll
            for (int d0 = 0; d0 < 4; ++d0) op[32 * d0] = (bf16)f2bf(o[d0][i] * rn * gs[d0]); }
    }
    __syncthreads();
}
}

namespace sg {
struct EpiZ {
    bf16* Z;
    __device__ __forceinline__ void operator()(int r, int c, const f32x4& a, int) const { const float sc = (c >= 512 && c < 1024) ? 0.18033688011112042f : 1.0f;
        v2u w; w.x = pk2(a.x * sc, a.y * sc); w.y = pk2(a.z * sc, a.w * sc); *(v2u*)(Z + (size_t)r * INW + c) = w; }
};
struct EpiSq {
    bf16* O;
    __device__ __forceinline__ void operator()(int r, int c, const f32x4& a, int) const { const float x = fmaxf(a.x, 0.f), y = fmaxf(a.y, 0.f), z = fmaxf(a.z, 0.f), w_ = fmaxf(a.w, 0.f);
        v2u w; w.x = pk2(x * x, y * y); w.y = pk2(z * z, w_ * w_); *(v2u*)(O + (size_t)r * DFF + c) = w; }
};
struct EpiR {
    const float* res32; const bf16* res16; bf16* out16; const float* gate;
    __device__ __forceinline__ void operator()(int r, int c, const f32x4& a, int) const { const f32x4 g = *(const f32x4*)(gate + c); f32x4 x;
        if (res16) { const v2u q = *(const v2u*)(res16 + (size_t)r * DM + c);
            x = (f32x4){__builtin_bit_cast(float, q.x << 16), __builtin_bit_cast(float, q.x & 0xffff0000u), __builtin_bit_cast(float, q.y << 16), __builtin_bit_cast(float, q.y & 0xffff0000u)}; }
        else x = *(const f32x4*)(res32 + (size_t)r * DM + c);
        const f32x4 o = x + g * a;
        v2u w; w.x = pk2(o.x, o.y); w.y = pk2(o.z, o.w); *(v2u*)(out16 + (size_t)r * DM + c) = w; }
};
struct EpiPart {
    float* P;
    __device__ __forceinline__ void operator()(int r, int c, const f32x4& a, int ks) const { *(f32x4*)(P + ((size_t)ks * 1024 + r) * DM + c) = a; }
};
template <int BN, class Epi, int BM = 64>
__device__ __forceinline__ void small_gemm(LAS unsigned char* lds, const bf16* A, const bf16* Bt, int M, int N, int K, const Epi& E, int tid, int lane, int wid, int KS = 1) {
    constexpr int BK = 128, MT = BM / 32, NTN = BN / 64, NAL = BM / 32, NBL = BN / 32, ABYTES = BM * BK * 2, BBYTES = BN * BK * 2, STAGE = ABYTES + BBYTES;
    const int nN = N / BN, nitems = (M / BM) * nN * KS, Kc = K / KS, nk = Kc / BK;
    const int wm = wid >> 2, wn = wid & 3, fr = lane & 15, fq = lane >> 4;
    const int srow = tid >> 4, sch = tid & 15;
    for (int item = blockIdx.x; item < nitems; item += gridDim.x) {
        const int ks = item % KS, tile = item / KS, pm = tile / nN, pn = tile % nN;
        const bf16* Ag = A + (size_t)(pm * BM + srow) * K + ks * Kc + sch * 8; const bf16* Bg = Bt + (size_t)(pn * BN + srow) * K + ks * Kc + sch * 8;
        f32x4 acc[MT][NTN];
#pragma unroll
        for (int m = 0; m < MT; ++m)
#pragma unroll
            for (int n = 0; n < NTN; ++n) acc[m][n] = (f32x4){0.f, 0.f, 0.f, 0.f};
        v4u ra[NAL], rb[NBL], ra2[NAL], rb2[NBL];
#define SG_LOAD(A_, B_, kt_) do { _Pragma("unroll") for (int j = 0; j < NAL; ++j) A_[j] = *(const v4u*)(Ag + (size_t)(32 * j) * K + (kt_) * BK); \
                          _Pragma("unroll") for (int j = 0; j < NBL; ++j) B_[j] = *(const v4u*)(Bg + (size_t)(32 * j) * K + (kt_) * BK); } while (0)
#define SG_STORE(A_, B_, b_) do { _Pragma("unroll") for (int j = 0; j < NAL; ++j) { const int r_ = srow + 32 * j; *(LAS v4u*)(lds + (b_) * STAGE + r_ * 256 + ((sch ^ (r_ & 15)) * 16)) = A_[j]; } \
                          _Pragma("unroll") for (int j = 0; j < NBL; ++j) { const int r_ = srow + 32 * j; *(LAS v4u*)(lds + (b_) * STAGE + ABYTES + r_ * 256 + ((sch ^ (r_ & 15)) * 16)) = B_[j]; } } while (0)
#define SG_COMPUTE(b_) do { const LAS unsigned char* sa = lds + (b_) * STAGE; const LAS unsigned char* sb = sa + ABYTES; \
            _Pragma("unroll") for (int kk = 0; kk < 4; ++kk) { bf16x8 af[MT], bfr[NTN]; \
                _Pragma("unroll") for (int m = 0; m < MT; ++m) { const int r_ = (BM / 2) * wm + 16 * m + fr; af[m] = *(const LAS bf16x8*)(sa + r_ * 256 + (((kk * 4 + fq) ^ (r_ & 15)) * 16)); } \
                _Pragma("unroll") for (int n = 0; n < NTN; ++n) { const int r_ = (BN / 4) * wn + 16 * n + fr; bfr[n] = *(const LAS bf16x8*)(sb + r_ * 256 + (((kk * 4 + fq) ^ (r_ & 15)) * 16)); } \
                _Pragma("unroll") for (int m = 0; m < MT; ++m) _Pragma("unroll") for (int n = 0; n < NTN; ++n) acc[m][n] = __builtin_amdgcn_mfma_f32_16x16x32_bf16(bfr[n], af[m], acc[m][n], 0, 0, 0); } } while (0)
        SG_LOAD(ra, rb, 0); SG_LOAD(ra2, rb2, 1); SG_STORE(ra, rb, 0);
        __syncthreads();
        for (int kt = 0; kt < nk; kt += 2) {
            if (kt + 2 < nk) SG_LOAD(ra, rb, kt + 2);
            SG_COMPUTE(0);
            SG_STORE(ra2, rb2, 1);
            __syncthreads();
            if (kt + 3 < nk) SG_LOAD(ra2, rb2, kt + 3);
            SG_COMPUTE(1);
            if (kt + 2 < nk) SG_STORE(ra, rb, 0);
            __syncthreads();
        }
#undef SG_COMPUTE
#undef SG_LOAD
#undef SG_STORE
#pragma unroll
        for (int m = 0; m < MT; ++m)
#pragma unroll
            for (int n = 0; n < NTN; ++n) E(pm * BM + (BM / 2) * wm + 16 * m + fr, pn * BN + (BN / 4) * wn + 16 * n + 4 * fq, acc[m][n], ks);
    }
}
}

#define XB_TMO      128
#define XB_XCNT(j)  (256  + 64 * (j))
#define XB_XSUB(j)  (1280 + 64 * (j))
#define XB_XGEN(j)  (2304 + 64 * (j))
#define XB_TOP      3328
#define XB_TOPGEN   3392
#define XCD_BAR_WORDS 3456
#define XB_SPIN_CAP (1u << 18)

__device__ __forceinline__ unsigned xb_ld(unsigned* p)              { return __hip_atomic_load(p, __ATOMIC_RELAXED, __HIP_MEMORY_SCOPE_AGENT); }
__device__ __forceinline__ unsigned xb_add(unsigned* p, unsigned v) { return __hip_atomic_fetch_add(p, v, __ATOMIC_RELAXED, __HIP_MEMORY_SCOPE_AGENT); }
__device__ __forceinline__ unsigned xb_xcc_id() { return (unsigned)__builtin_amdgcn_s_getreg((3 << 11) | 20) & 0xFu; }
#define XB_SPIN(cond, bar) do { unsigned _sp = 0; while (cond) { __builtin_amdgcn_s_sleep(1); \
    if ((++_sp & 255u) == 0u) { if (xb_ld(&(bar)[XB_TMO])) break; if (_sp > XB_SPIN_CAP) { atomicAdd(&(bar)[XB_TMO], 1u); break; } } } } while (0)

struct XcdBarrier {
    unsigned* bar; unsigned x;
    volatile LAS unsigned* st;
};

__device__ __forceinline__ XcdBarrier xcd_barrier_post(unsigned* bar, volatile LAS unsigned* st) {
    XcdBarrier b; b.bar = bar; b.x = (unsigned)__builtin_amdgcn_readfirstlane((int)xb_xcc_id()); b.st = st;
    if (threadIdx.x == 0) (void)xb_add(&bar[XB_XCNT(b.x)], 1u);
    return b;
}
__device__ __forceinline__ void xcd_barrier_complete(unsigned* bar, unsigned x, unsigned& nloc, unsigned& nx) {
    const unsigned G = gridDim.x * gridDim.y * gridDim.z;
    unsigned sum, cnt, mine, sp = 0u;
    for (;;) {
        sum = 0u; cnt = 0u; mine = 0u;
#pragma unroll
        for (unsigned j = 0; j < 16; ++j) { const unsigned c = xb_ld(&bar[XB_XCNT(j)]); sum += c; cnt += (c > 0u) ? 1u : 0u; mine = (j == x) ? c : mine; }
        if (sum == G) break;
        __builtin_amdgcn_s_sleep(1);
        if ((++sp & 255u) == 0u) { if (xb_ld(&bar[XB_TMO])) break; if (sp > XB_SPIN_CAP) { atomicAdd(&bar[XB_TMO], 1u); break; } }
    }
    nloc = mine > 0u ? mine : 1u; nx = cnt > 0u ? cnt : 1u;
}

__device__ __forceinline__ void xcd_barrier(const XcdBarrier& b) {
    asm volatile("s_waitcnt vmcnt(0)" ::: "memory");
    __syncthreads();
    if (threadIdx.x == 0) {
        unsigned* bar = b.bar;
        unsigned bx_ = b.x; asm volatile("" : "+s"(bx_));
        __builtin_amdgcn_s_waitcnt(0);
        unsigned nloc = b.st[0], nx = b.st[1];
        if (nloc == 0u) { xcd_barrier_complete(bar, bx_, nloc, nx); b.st[0] = nloc; b.st[1] = nx; }
        const unsigned old = xb_add(&bar[XB_XSUB(bx_)], 1u);
        const unsigned gen = old / nloc;
        if (old + 1u == (gen + 1u) * nloc) {
            __builtin_amdgcn_fence(__ATOMIC_RELEASE, "agent");
            asm volatile("s_waitcnt vmcnt(0)" ::: "memory");
            const unsigned og = xb_add(&bar[XB_TOP], 1u);
            const unsigned tg = og / nx;
            if (og + 1u == (tg + 1u) * nx) xb_add(&bar[XB_TOPGEN], 1u);
            else XB_SPIN(xb_ld(&bar[XB_TOPGEN]) == tg, bar);
            __builtin_amdgcn_fence(__ATOMIC_ACQUIRE, "agent");
            xb_add(&bar[XB_XGEN(bx_)], 1u);
            asm volatile("s_waitcnt vmcnt(0)" ::: "memory");
        } else {
            XB_SPIN(xb_ld(&bar[XB_XGEN(bx_)]) == gen, bar);
            __builtin_amdgcn_fence(__ATOMIC_ACQUIRE, "agent");
            asm volatile("s_waitcnt vmcnt(0)" ::: "memory");
        }
    }
    __syncthreads();
}

__global__ void __launch_bounds__(512, 2) mega_fwd(Params p) {
    extern __shared__ __attribute__((aligned(16))) unsigned char lds_raw[];
    LAS unsigned char* lds = (LAS unsigned char*)lds_raw;
    cg::grid_group grid = cg::this_grid();
    int tid = threadIdx.x, lane = tid & 63, wid = __builtin_amdgcn_readfirstlane(tid >> 6);
#define OPAQUE_TID() do { tid = threadIdx.x; asm volatile("" : "+v"(tid)); lane = tid & 63; wid = __builtin_amdgcn_readfirstlane(tid >> 6); } while (0)
    const int G = gridDim.x, bx = blockIdx.x;
    const int vcu = (G % 8 == 0) ? (bx % 8) * (G / 8) + bx / 8 : bx;
    unsigned char* ws = p.ws;
    if (tid < 16) ((LAS unsigned*)(lds + LDS_CTL))[tid] = 0u;
    __syncthreads();
    const XcdBarrier xbar = xcd_barrier_post((unsigned*)(ws + WS_BAR), (volatile LAS unsigned*)(lds + LDS_CTL));
    float* ada = (float*)(ws + WS_ADA);
    const float* cosT = (const float*)(ws + WS_ROPE); const float* sinT = cosT + 4096 * 32;
    bf16* X16 = (bf16*)(ws + WS_X);
    bf16* H = (bf16*)(ws + WS_H); bf16* Z = (bf16*)(ws + WS_Z); bf16* MIX = (bf16*)(ws + WS_MIX); bf16* A = (bf16*)(ws + WS_A);

#ifndef NO_PRO
    for (int rep_ = 0; rep_ < REP_N; ++rep_) { prologue(p, lds, tid, lane, wid); __syncthreads(); }
#endif
    if (ws == nullptr) grid.sync();
    xcd_barrier(xbar);

    for (int l = 0; l < NLAYER; ++l) {
        const bool last = (l == NLAYER - 1);
        const int rows2 = last ? MLAT : MTOT;
        const unsigned char* wl = ws + WS_W + (size_t)l * W_LAYER;
        const float* adal = ada + (size_t)l * 5 * NADA;
        const bool l0 = (l == 0);

        OPAQUE_TID();
        if (l0) norm_mod_phase(p.x, p.ctx, p.g_mix + l * DM, adal, 0, H, MTOT, lane, wid);
        else norm_mod_phase16(X16, p.g_mix + l * DM, adal, 0, H, MTOT, lane, wid, (const float*)(ws + WS_PART), ada + ((size_t)(l - 1) * 5 + 4) * NADA + 5 * DM);
        GSYNC();
        { pg8::Gemm g{H, (const bf16*)(wl + WO_IN), MLAT, INW, DM}; pg8::StaticOrder S; S.init(MLAT, INW, G, bx);
          pg8::EpiInProj E{Z, cosT, sinT};
          for (int rep_ = 0; rep_ < REP_G; ++rep_) pg8::gemm_phase<pg8::EpiInProj, pg8::StaticOrder, true, true>(lds, g, S, E); }
        { OPAQUE_TID(); sg::EpiZ E{Z + (size_t)MLAT * INW};
          sg::small_gemm<128, sg::EpiZ>(lds, H + (size_t)MLAT * DM, (const bf16*)(wl + WO_IN), MTOT - MLAT, INW, DM, E, tid, lane, wid); }
        GSYNC();
        OPAQUE_TID();
        {
            float lam, lam_init = 0.8f - 0.6f * __expf(-0.3f * (float)l);
            { const float a = p.lq1[l * 64 + lane] * p.lk1[l * 64 + lane], c2 = p.lq2[l * 64 + lane] * p.lk2[l * 64 + lane];
              lam = __expf(wave_sum(a, lane)) - __expf(wave_sum(c2, lane)) + lam_init; }
            const float oscale = 1.0f - lam_init;
            const float* gsub = p.g_sub + l * 128;
            _Pragma("nounroll") for (int rep_ = 0; rep_ < REP_ATT; ++rep_) {
            const int natt = last ? 512 : 544;
            _Pragma("nounroll") for (int u = vcu; u < natt; u += G) {
                OPAQUE_TID();
                int b, h, qrow0, NT; bool latent;
                if (u < 512) { const int bh = u >> 5, qb = u & 31; b = bh >> 2; h = bh & 3; qrow0 = b * SEQ + qb * 128; NT = 68; latent = true; }
                else { const int v = u - 512, bh = v >> 1, qb = v & 1; b = bh >> 2; h = bh & 3; qrow0 = MLAT + b * CTXL + qb * 128; NT = 4; latent = false; }
                att::attn_unit(lds, Z, MIX, b, h, qrow0, NT, latent, lam, oscale, gsub, tid, lane, wid);
            }
            const int nctx = last ? 0 : 32, NE = nctx + (last ? 256 : 272);
            _Pragma("nounroll") for (int r = 0; r * G < NE; ++r) { const int e = r * G + ((r & 1) ? G - 1 - vcu : vcu);
                if (e >= nctx && e < NE) { OPAQUE_TID(); pool_unit(lds, Z, MIX, (const bf16*)(wl + WO_P), p.s_pool + l * 512, e - nctx, tid, lane, wid); } }
            }
        }
        GSYNC();
        { pg8::Gemm g{MIX, (const bf16*)(wl + WO_OUT), MLAT, DM, DM}; pg8::StaticOrder S; S.init(MLAT, DM, G, bx);
          pg8::EpiRes E{p.x, p.ctx, l0 ? (const bf16*)nullptr : (const bf16*)X16, X16, adal + 2 * DM};
          pg8::gemm_phase<pg8::EpiRes, pg8::StaticOrder, true, true>(lds, g, S, E); }
        if (!last) { OPAQUE_TID(); sg::EpiR E{p.ctx, l0 ? (const bf16*)nullptr : (const bf16*)(X16 + (size_t)MLAT * DM), X16 + (size_t)MLAT * DM, adal + 4 * NADA + 2 * DM};
          sg::small_gemm<64, sg::EpiR>(lds, MIX + (size_t)MLAT * DM, (const bf16*)(wl + WO_OUT), MTOT - MLAT, DM, DM, E, tid, lane, wid); }
        GSYNC();
        OPAQUE_TID();
        norm_mod_phase16(X16, p.g_mlp + l * DM, adal, 3, H, rows2, lane, wid);
        GSYNC();
        { pg8::Gemm g{H, (const bf16*)(wl + WO_1), MLAT, DFF, DM}; pg8::StaticOrder S; S.init(MLAT, DFF, G, bx);
          pg8::EpiSqRelu E{A, DFF};
          for (int rep_ = 0; rep_ < REP_G; ++rep_) pg8::gemm_phase<pg8::EpiSqRelu, pg8::StaticOrder, true, true>(lds, g, S, E); }
        if (!last) { OPAQUE_TID(); sg::EpiSq E{A + (size_t)MLAT * DFF};
          sg::small_gemm<128, sg::EpiSq, 128>(lds, H + (size_t)MLAT * DM, (const bf16*)(wl + WO_1), MTOT - MLAT, DFF, DM, E, tid, lane, wid); }
        GSYNC();
        { pg8::Gemm g{A, (const bf16*)(wl + WO_2), MLAT, DM, DFF}; pg8::StaticOrder S; S.init(MLAT, DM, G, bx);
          pg8::EpiRes E{p.x, p.ctx, X16, X16, adal + 5 * DM};
          pg8::gemm_phase<pg8::EpiRes, pg8::StaticOrder, true, true>(lds, g, S, E); }
        if (!last) { OPAQUE_TID(); sg::EpiPart E{(float*)(ws + WS_PART)};
          sg::small_gemm<128, sg::EpiPart, 128>(lds, A + (size_t)MLAT * DFF, (const bf16*)(wl + WO_2), MTOT - MLAT, DM, DFF, E, tid, lane, wid, 4); }
        GSYNC();
    }
    OPAQUE_TID();
    final_norm_phase(X16, p.g_final, p.out, lane, wid);
}

extern "C" void kernel_launch(void* const* d_in, const int* in_sizes, int n_in, void* d_out, int out_size, void* d_ws, size_t ws_size, hipStream_t stream) {
    static int grid = 0;
    if (grid == 0) {
        if (n_in != 20 || ws_size < WS_END) { fprintf(stderr, "kernel_launch: unexpected n_in %d or ws_size %zu (< %zu)\n", n_in, ws_size, (size_t)WS_END); }
        int dev = 0, cus = 0, per_cu = 0;
        (void)hipGetDevice(&dev);
        (void)hipDeviceGetAttribute(&cus, hipDeviceAttributeMultiprocessorCount, dev);
        (void)hipFuncSetAttribute((const void*)mega_fwd, hipFuncAttributeMaxDynamicSharedMemorySize, LDS_BYTES);
        (void)hipOccupancyMaxActiveBlocksPerMultiprocessor(&per_cu, (const void*)mega_fwd, 512, LDS_BYTES);
        if (per_cu < 1) per_cu = 1;
        grid = cus * per_cu;
        fprintf(stderr, "kernel_launch: grid %d (cus %d x %d)\n", grid, cus, per_cu);
    }
    (void)hipMemsetAsync((unsigned char*)d_ws + WS_BAR, 0, WS_BAR_BYTES, stream);
    Params p{};
    const float** pp = (const float**)&p;
    for (int i = 0; i < 20; ++i) pp[i] = (const float*)d_in[i];
    p.out = (float*)d_out; p.ws = (unsigned char*)d_ws;
    void* args[] = {&p};
    hipError_t e = hipLaunchCooperativeKernel((const void*)mega_fwd, dim3(grid), dim3(512), args, LDS_BYTES, stream);
    if (e != hipSuccess) fprintf(stderr, "cooperative launch failed: %s (grid %d)\n", hipGetErrorString(e), grid);
}
```

```cpp
#include <hip/hip_runtime.h>
#include <hip/hip_cooperative_groups.h>
#include <hip/hip_bf16.h>
#include <cstdio>
#include <cstdint>
namespace cg = cooperative_groups;
#ifndef REP_ATT
#define REP_ATT 1
#endif
#ifndef REP_G
#define REP_G 1
#endif
#ifndef REP_N
#define REP_N 1
#endif
#ifndef REP_SYNC
#define REP_SYNC 1
#endif
#define GSYNC() do { for (int r_ = 0; r_ < REP_SYNC; ++r_) xcd_barrier(xbar); } while (0)
namespace pg8 {
#define PG8_LAS __attribute__((address_space(3)))
typedef unsigned short bf16_t;
typedef short bf16x8 __attribute__((ext_vector_type(8)));
typedef float f32x4 __attribute__((ext_vector_type(4)));
typedef unsigned u32x4 __attribute__((ext_vector_type(4)));
constexpr int BM = 256, BK = 64, HALF = 128, HTB = HALF * BK * 2  , STAGE_BYTES = 8 * HTB, NXCD = 8, WGM = 8;

__host__ __device__ __forceinline__ int lds_byte(int r, int c) { const int st = (r >> 4) * 2 + (c >> 5), rr = r & 15, cc = c & 31, ob = rr * 64 + cc * 2; return st * 1024 + (ob ^ (((ob >> 9) & 1) << 5)); }
__host__ __device__ __forceinline__ void stage_rc(int b, int& R, int& C) { const int st = b / 1024, sb = b % 1024, swz = sb ^ (((sb >> 9) & 1) << 5); R = (st >> 1) * 16 + swz / 64; C = (st & 1) * 32 + (swz % 64) / 2; }
__host__ __device__ __forceinline__ int perm32(int rho) { const int n = rho >> 4, i = rho & 15; return 8 * (i >> 2) + 4 * n + (i & 3); }

struct Unit { int pm, pn; };
struct Gemm { const bf16_t* A; const bf16_t* Bt; int M, N, K; };

struct StaticOrder {
    int nM, nN, nwg, G, c;
    __host__ __device__ void init(int M, int N, int G_, int c_) { nM = M / BM; nN = N / BM; nwg = nM * nN; G = G_; c = c_; }
    __host__ __device__ bool next(int i, Unit& u) const {
        const long L = (long)i * G + c; if (L >= nwg) return false;
        int wgid = (int)L; { const int q = nwg / NXCD, r = nwg % NXCD, xcd = wgid % NXCD, off = wgid / NXCD; wgid = (xcd < r ? xcd * (q + 1) : r * (q + 1) + (xcd - r) * q) + off; }
        const int nig = WGM * nN, gid = wgid / nig, fm = gid * WGM, gsz = (nM - fm) < WGM ? (nM - fm) : WGM;
        u.pm = fm + ((wgid % nig) % gsz); u.pn = (wgid % nig) / gsz; return true;
    }
    __device__ __forceinline__ void a_ready(const Unit&) const {}
    __device__ __forceinline__ void done(const Unit&) const {}
};

__device__ __forceinline__ unsigned cvt_pk_bf16(float lo, float hi) { unsigned r; asm volatile("v_cvt_pk_bf16_f32 %0, %1, %2" : "=v"(r) : "v"(lo), "v"(hi)); return r; }
typedef float f32x2 __attribute__((ext_vector_type(2)));
struct EpiInProj {
    static constexpr bool PERM = true, AFTER_DRAIN = false;
    bf16_t* Z; const float* cosT; const float* sinT;
    __device__ __forceinline__ void operator()(const f32x4 (&acc)[2][2][4][2], const Unit& u, int wr, int wc, int fr, int fq) const {
        const int row0 = u.pm * BM + wr * 64 + fr, colt = u.pn * BM, region = colt >> 9;
        const bool rope = (region == 1 || region == 2) && (u.pm < 64);
        const float sc = (region == 1) ? 0.18033688011112042f : 1.0f;
        const int col0 = colt + wc * 32 + 8 * fq, i0 = (wc & 1) * 16 + 4 * fq;
        f32x4 inv4;
#pragma unroll
        for (int jj = 0; jj < 4; ++jj) inv4[jj] = __builtin_amdgcn_exp2f(-(float)((i0 & 15) + jj) * (13.287712379549449f / 16.0f));
#pragma unroll
        for (int ai = 0; ai < 2; ++ai)
#pragma unroll
            for (int m = 0; m < 4; ++m) {
                const int row = row0 + ai * HALF + m * 16;
                f32x4 cs = (f32x4){1.f, 1.f, 1.f, 1.f}, sn = (f32x4){0.f, 0.f, 0.f, 0.f};
                if (rope) { const int t = row & 4095; const float pos = (float)((i0 < 16) ? (t >> 6) : (t & 63));
#pragma unroll
                    for (int jj = 0; jj < 4; ++jj) { const float ang = pos * inv4[jj]; cs[jj] = __cosf(ang); sn[jj] = __sinf(ang); } }
                bf16_t* rowp = Z + (size_t)row * 2048 + col0;
#pragma unroll
                for (int bj = 0; bj < 2; ++bj) {
                    const f32x4 v0 = acc[ai][bj][m][0], v1 = acc[ai][bj][m][1];
                    f32x4 o0, o1;
                    o0[0] = v0[0] * cs[0] - v0[1] * sn[0]; o0[1] = v0[0] * sn[0] + v0[1] * cs[0];
                    o0[2] = v0[2] * cs[1] - v0[3] * sn[1]; o0[3] = v0[2] * sn[1] + v0[3] * cs[1];
                    o1[0] = v1[0] * cs[2] - v1[1] * sn[2]; o1[1] = v1[0] * sn[2] + v1[1] * cs[2];
                    o1[2] = v1[2] * cs[3] - v1[3] * sn[3]; o1[3] = v1[2] * sn[3] + v1[3] * cs[3];
                    o0 = o0 * sc; o1 = o1 * sc;
                    u32x4 w; w.x = cvt_pk_bf16(o0[0], o0[1]); w.y = cvt_pk_bf16(o0[2], o0[3]); w.z = cvt_pk_bf16(o1[0], o1[1]); w.w = cvt_pk_bf16(o1[2], o1[3]);
                    *(u32x4*)(rowp + bj * HALF) = w;
                }
            }
    }
};
struct EpiSqRelu {
    static constexpr bool PERM = true, AFTER_DRAIN = false;
    bf16_t* O; int ldc;
    __device__ __forceinline__ void operator()(const f32x4 (&acc)[2][2][4][2], const Unit& u, int wr, int wc, int fr, int fq) const {
        const int row0 = u.pm * BM + wr * 64 + fr, col0 = u.pn * BM + wc * 32 + 8 * fq;
#pragma unroll
        for (int ai = 0; ai < 2; ++ai)
#pragma unroll
            for (int m = 0; m < 4; ++m) { bf16_t* rowp = O + (size_t)(row0 + ai * HALF + m * 16) * ldc + col0;
#pragma unroll
                for (int bj = 0; bj < 2; ++bj) { f32x4 v0 = acc[ai][bj][m][0], v1 = acc[ai][bj][m][1];
#pragma unroll
                    for (int j = 0; j < 4; ++j) { const float a = fmaxf(v0[j], 0.f), b = fmaxf(v1[j], 0.f); v0[j] = a * a; v1[j] = b * b; }
                    u32x4 w; w.x = cvt_pk_bf16(v0[0], v0[1]); w.y = cvt_pk_bf16(v0[2], v0[3]); w.z = cvt_pk_bf16(v1[0], v1[1]); w.w = cvt_pk_bf16(v1[2], v1[3]);
                    *(u32x4*)(rowp + bj * HALF) = w; } }
    }
};
struct EpiRes {
    static constexpr bool PERM = true, AFTER_DRAIN = false;
    const float* res_lat32; const float* res_ctx32; const bf16_t* res16; bf16_t* out16; const float* gate;
    __device__ __forceinline__ void operator()(const f32x4 (&acc)[2][2][4][2], const Unit& u, int wr, int wc, int fr, int fq) const {
        const int row0 = u.pm * BM + wr * 64 + fr, col0 = u.pn * BM + wc * 32 + 8 * fq;
        const bool lat = u.pm < 64; const int b = lat ? (u.pm >> 4) : 4;
        const float* gp = gate + (size_t)b * 6144 + col0;
        f32x4 gv[2][2];
#pragma unroll
        for (int bj = 0; bj < 2; ++bj)
#pragma unroll
            for (int n = 0; n < 2; ++n) gv[bj][n] = *(const f32x4*)(gp + bj * HALF + 4 * n);
        if (res16) {
#pragma unroll
            for (int ai = 0; ai < 2; ++ai) {
                u32x4 rq[4][2];
#pragma unroll
                for (int m = 0; m < 4; ++m)
#pragma unroll
                    for (int bj = 0; bj < 2; ++bj) rq[m][bj] = *(const u32x4*)(res16 + (size_t)(row0 + ai * HALF + m * 16) * 1024 + col0 + bj * HALF);
#pragma unroll
                for (int m = 0; m < 4; ++m) { bf16_t* op = out16 + (size_t)(row0 + ai * HALF + m * 16) * 1024 + col0;
#pragma unroll
                    for (int bj = 0; bj < 2; ++bj) { const u32x4 q = rq[m][bj];
                        const f32x4 r0 = (f32x4){__builtin_bit_cast(float, q.x << 16), __builtin_bit_cast(float, q.x & 0xffff0000u), __builtin_bit_cast(float, q.y << 16), __builtin_bit_cast(float, q.y & 0xffff0000u)};
                        const f32x4 r1 = (f32x4){__builtin_bit_cast(float, q.z << 16), __builtin_bit_cast(float, q.z & 0xffff0000u), __builtin_bit_cast(float, q.w << 16), __builtin_bit_cast(float, q.w & 0xffff0000u)};
                        const f32x4 o0 = r0 + gv[bj][0] * acc[ai][bj][m][0], o1 = r1 + gv[bj][1] * acc[ai][bj][m][1];
                        u32x4 w; w.x = cvt_pk_bf16(o0[0], o0[1]); w.y = cvt_pk_bf16(o0[2], o0[3]); w.z = cvt_pk_bf16(o1[0], o1[1]); w.w = cvt_pk_bf16(o1[2], o1[3]);
                        *(u32x4*)(op + bj * HALF) = w; } }
            }
        } else {
#pragma unroll
            for (int ai = 0; ai < 2; ++ai)
#pragma unroll
                for (int mh = 0; mh < 2; ++mh) {
                    f32x4 rf[2][2][2];
#pragma unroll
                    for (int mm = 0; mm < 2; ++mm) { const int row = row0 + ai * HALF + (2 * mh + mm) * 16;
                        const float* rp = (lat ? res_lat32 + (size_t)row * 1024 : res_ctx32 + (size_t)(row - 16384) * 1024) + col0;
#pragma unroll
                        for (int bj = 0; bj < 2; ++bj) { rf[mm][bj][0] = *(const f32x4*)(rp + bj * HALF); rf[mm][bj][1] = *(const f32x4*)(rp + bj * HALF + 4); } }
#pragma unroll
                    for (int mm = 0; mm < 2; ++mm) { const int m = 2 * mh + mm; bf16_t* op = out16 + (size_t)(row0 + ai * HALF + m * 16) * 1024 + col0;
#pragma unroll
                        for (int bj = 0; bj < 2; ++bj) { const f32x4 o0 = rf[mm][bj][0] + gv[bj][0] * acc[ai][bj][m][0], o1 = rf[mm][bj][1] + gv[bj][1] * acc[ai][bj][m][1];
                            u32x4 w; w.x = cvt_pk_bf16(o0[0], o0[1]); w.y = cvt_pk_bf16(o0[2], o0[3]); w.z = cvt_pk_bf16(o1[0], o1[1]); w.w = cvt_pk_bf16(o1[2], o1[3]);
                            *(u32x4*)(op + bj * HALF) = w; } }
                }
        }
    }
};
template <class Epi, class Sched, bool ALIGN_EPI = false, bool SP2 = false>
__device__ __forceinline__ void gemm_phase(PG8_LAS unsigned char* lds, const Gemm g, const Sched& S, const Epi& E) {
    int tid = threadIdx.x; asm volatile("" : "+v"(tid));
    const int wid = __builtin_amdgcn_readfirstlane(tid >> 6), lane = tid & 63, wr = wid >> 2, wc = wid & 3, fr = lane & 15, fq = lane >> 4;
    const int K = g.K, nt = K / BK;
    unsigned voffA[2], voffB[2];
#pragma unroll
    for (int i = 0; i < 2; ++i) { int R, C; stage_rc(tid * 16 + i * 8192, R, C); const int Rb = Epi::PERM ? ((R & ~31) + perm32(R & 31)) : R;
        voffA[i] = (unsigned)(R * K + C) * 2u; voffB[i] = (unsigned)(Rb * K + C) * 2u; }
    const size_t kstep = (size_t)(BK * 2);
    const size_t hstep = (size_t)HALF * K * 2;
    const size_t tstep = 2 * hstep;
    const unsigned ldsw = (unsigned)wid * 1024u;
    const int aoff = lds_byte(wr * 64 + fr, fq * 8), boff = lds_byte(wc * 32 + fr, fq * 8);
#define PG8_SA(b, h) (((b) * 2 + (h)) * HTB)
#define PG8_SB(b, h) ((4 + (b) * 2 + (h)) * HTB)
#define PG8_STAGE(bufoff, gbase, voff) do { _Pragma("unroll") for (int _i = 0; _i < 2; ++_i) \
        __builtin_amdgcn_global_load_lds((const unsigned*)((const char*)(gbase) + (voff)[_i]), (PG8_LAS unsigned*)(lds + (bufoff) + ldsw + _i * 8192), 16, 0, 0); } while (0)
#define PG8_LDA(dst, b, h) do { _Pragma("unroll") for (int m = 0; m < 4; ++m) _Pragma("unroll") for (int k = 0; k < 2; ++k) dst[m][k] = *(const PG8_LAS bf16x8*)(lds + PG8_SA(b, h) + aoff + m * 2048 + k * 1024); } while (0)
#define PG8_LDB(dst, b, h) do { _Pragma("unroll") for (int n = 0; n < 2; ++n) _Pragma("unroll") for (int k = 0; k < 2; ++k) dst[n][k] = *(const PG8_LAS bf16x8*)(lds + PG8_SB(b, h) + boff + n * 2048 + k * 1024); } while (0)
#define PG8_MMA(ai, bj, At, Bt) do { __builtin_amdgcn_s_setprio(1); _Pragma("unroll") for (int m = 0; m < 4; ++m) _Pragma("unroll") for (int n = 0; n < 2; ++n) _Pragma("unroll") for (int k = 0; k < 2; ++k) \
        acc[ai][bj][m][n] = __builtin_amdgcn_mfma_f32_16x16x32_bf16(Bt[n][k], At[m][k], acc[ai][bj][m][n], 0, 0, 0); __builtin_amdgcn_s_setprio(0); } while (0)
#define PG8_WAIT_V(n) asm volatile("s_waitcnt vmcnt(" #n ")" ::: "memory")
#define PG8_WAIT_L(n) asm volatile("s_waitcnt lgkmcnt(" #n ")" ::: "memory")
#define PG8_BAR __builtin_amdgcn_s_barrier()
#define PG8_SCHED __builtin_amdgcn_sched_barrier(0)
    Unit cur, nxt; int ui = 0;
    if (!S.next(0, cur)) return;
    f32x4 acc[2][2][4][2];
#pragma unroll
    for (int a = 0; a < 2; ++a)
#pragma unroll
        for (int b = 0; b < 2; ++b)
#pragma unroll
            for (int m = 0; m < 4; ++m)
#pragma unroll
                for (int n = 0; n < 2; ++n) acc[a][b][m][n] = (f32x4){0.f, 0.f, 0.f, 0.f};
    bf16x8 At[4][2], B0[2][2], B1[2][2];
    const char* cA = (const char*)g.A + (size_t)cur.pm * tstep; const char* cB = (const char*)g.Bt + (size_t)cur.pn * tstep;
    S.a_ready(cur);
    if constexpr (SP2) {
        PG8_STAGE(PG8_SB(0, 0), cB, voffB); PG8_STAGE(PG8_SB(0, 1), cB + hstep, voffB); PG8_STAGE(PG8_SA(0, 0), cA, voffA); PG8_STAGE(PG8_SA(0, 1), cA + hstep, voffA);
        if (wr == 1) PG8_BAR;
        PG8_WAIT_V(2); PG8_BAR;
        PG8_STAGE(PG8_SB(1, 0), cB + kstep, voffB); PG8_STAGE(PG8_SA(1, 0), cA + kstep, voffA); PG8_STAGE(PG8_SB(1, 1), cB + hstep + kstep, voffB);
        PG8_WAIT_V(6); PG8_BAR;
    } else {
        PG8_STAGE(PG8_SB(0, 0), cB, voffB); PG8_STAGE(PG8_SA(0, 0), cA, voffA); PG8_STAGE(PG8_SB(0, 1), cB + hstep, voffB); PG8_STAGE(PG8_SA(0, 1), cA + hstep, voffA);
        if (wr == 1) PG8_BAR;
        PG8_WAIT_V(4); PG8_BAR;
        PG8_STAGE(PG8_SB(1, 0), cB + kstep, voffB); PG8_STAGE(PG8_SA(1, 0), cA + kstep, voffA); PG8_STAGE(PG8_SB(1, 1), cB + hstep + kstep, voffB);
        PG8_WAIT_V(6); PG8_BAR;
    }
    for (;;) {
        const bool has_next = S.next(ui + 1, nxt);
        const char* nA = has_next ? (const char*)g.A + (size_t)nxt.pm * tstep : cA; const char* nB = has_next ? (const char*)g.Bt + (size_t)nxt.pn * tstep : cB;
        for (int t = 0; t < nt; t += 2) {
            const bool last = (t == nt - 2);
            const char* a1 = cA + (size_t)(t + 1) * kstep;
            const char* a2 = last ? nA : cA + (size_t)(t + 2) * kstep; const char* b2 = last ? nB : cB + (size_t)(t + 2) * kstep;
            const char* a3 = a2 + kstep; const char* b3 = b2 + kstep;
            if (last && has_next) S.a_ready(nxt);
            if constexpr (SP2) {
            PG8_LDB(B0, 0, 0); PG8_LDB(B1, 0, 1); PG8_SCHED; PG8_LDA(At, 0, 0); PG8_STAGE(PG8_SA(1, 1), a1 + hstep, voffA);
            PG8_WAIT_V(8); PG8_WAIT_L(0); PG8_BAR; PG8_MMA(0, 0, At, B0); PG8_MMA(0, 1, At, B1); PG8_BAR; PG8_SCHED;
            PG8_LDA(At, 0, 1); PG8_STAGE(PG8_SB(0, 0), b2, voffB); PG8_STAGE(PG8_SB(0, 1), b2 + hstep, voffB); PG8_STAGE(PG8_SA(0, 0), a2, voffA);
            PG8_WAIT_V(8); PG8_WAIT_L(0); PG8_BAR; PG8_MMA(1, 0, At, B0); PG8_MMA(1, 1, At, B1); PG8_BAR; PG8_SCHED;
            PG8_LDB(B0, 1, 0); PG8_LDB(B1, 1, 1); PG8_SCHED; PG8_LDA(At, 1, 0); PG8_STAGE(PG8_SA(0, 1), a2 + hstep, voffA);
            PG8_WAIT_V(8); PG8_WAIT_L(0); PG8_BAR; PG8_MMA(0, 0, At, B0); PG8_MMA(0, 1, At, B1); PG8_BAR; PG8_SCHED;
            PG8_LDA(At, 1, 1); PG8_STAGE(PG8_SB(1, 0), b3, voffB); PG8_STAGE(PG8_SB(1, 1), b3 + hstep, voffB); PG8_STAGE(PG8_SA(1, 0), a3, voffA);
            PG8_WAIT_V(8); PG8_WAIT_L(0); PG8_BAR; PG8_MMA(1, 0, At, B0); PG8_MMA(1, 1, At, B1); PG8_BAR; PG8_SCHED;
            } else {
            PG8_LDB(B0, 0, 0); PG8_SCHED; PG8_LDA(At, 0, 0); PG8_STAGE(PG8_SA(1, 1), a1 + hstep, voffA);
            PG8_WAIT_L(8); PG8_BAR; PG8_WAIT_L(0); PG8_MMA(0, 0, At, B0); PG8_BAR; PG8_SCHED;
            PG8_LDB(B1, 0, 1); PG8_STAGE(PG8_SB(0, 0), b2, voffB);
            PG8_BAR; PG8_WAIT_L(0); PG8_MMA(0, 1, At, B1); PG8_BAR;
            PG8_LDA(At, 0, 1); PG8_STAGE(PG8_SA(0, 0), a2, voffA);
            PG8_BAR; PG8_WAIT_L(0); PG8_MMA(1, 0, At, B0); PG8_BAR; PG8_SCHED;
            PG8_STAGE(PG8_SB(0, 1), b2 + hstep, voffB);
            PG8_WAIT_V(6); PG8_BAR; PG8_MMA(1, 1, At, B1); PG8_BAR;
            PG8_LDB(B0, 1, 0); PG8_SCHED; PG8_LDA(At, 1, 0); PG8_STAGE(PG8_SA(0, 1), a2 + hstep, voffA);
            PG8_WAIT_L(8); PG8_BAR; PG8_WAIT_L(0); PG8_MMA(0, 0, At, B0); PG8_BAR; PG8_SCHED;
            PG8_LDB(B1, 1, 1); PG8_STAGE(PG8_SB(1, 0), b3, voffB);
            PG8_BAR; PG8_WAIT_L(0); PG8_MMA(0, 1, At, B1); PG8_BAR;
            PG8_LDA(At, 1, 1); PG8_STAGE(PG8_SA(1, 0), a3, voffA);
            PG8_BAR; PG8_WAIT_L(0); PG8_MMA(1, 0, At, B0); PG8_BAR; PG8_SCHED;
            PG8_STAGE(PG8_SB(1, 1), b3 + hstep, voffB);
            PG8_WAIT_V(6); PG8_BAR; PG8_MMA(1, 1, At, B1); PG8_BAR;
            }
        }
        if constexpr (ALIGN_EPI) { if (wr == 0) PG8_BAR; }
        if constexpr (!Epi::AFTER_DRAIN) { E(acc, cur, wr, wc, fr, fq); S.done(cur); }
        if (!has_next) break;
#pragma unroll
        for (int a = 0; a < 2; ++a)
#pragma unroll
            for (int b = 0; b < 2; ++b)
#pragma unroll
                for (int m = 0; m < 4; ++m)
#pragma unroll
                    for (int n = 0; n < 2; ++n) acc[a][b][m][n] = (f32x4){0.f, 0.f, 0.f, 0.f};
        cur = nxt; cA = nA; cB = nB; ++ui;
        if constexpr (ALIGN_EPI) { if (wr == 1) PG8_BAR; }
    }
    PG8_WAIT_V(0);
    if constexpr (!ALIGN_EPI) { if (wr == 0) PG8_BAR; }
    PG8_BAR;
    if constexpr (Epi::AFTER_DRAIN) { E.fused(acc, cur, wr, wc, fr, fq, lds, wid, lane); S.done(cur); }
#undef PG8_SA
#undef PG8_SB
#undef PG8_STAGE
#undef PG8_LDA
#undef PG8_LDB
#undef PG8_MMA
#undef PG8_WAIT_V
#undef PG8_WAIT_L
#undef PG8_BAR
#undef PG8_SCHED
}
}

#define LAS __attribute__((address_space(3)))
typedef unsigned short bf16;
typedef unsigned v4u __attribute__((ext_vector_type(4)));
typedef unsigned v2u __attribute__((ext_vector_type(2)));
typedef float f32x4 __attribute__((ext_vector_type(4)));
typedef float f32x2 __attribute__((ext_vector_type(2)));
typedef float f32x16 __attribute__((ext_vector_type(16)));
typedef short bf16x8 __attribute__((ext_vector_type(8)));
typedef short s16x4 __attribute__((ext_vector_type(4)));

constexpr int DM = 1024, SEQ = 4096, CTXL = 256, NBATCH = 4, MLAT = 16384, MTOT = 17408, INW = 2048, DFF = 4096, NLAYER = 4, NADA = 6144;
constexpr size_t MiB = 1u << 20;
constexpr size_t WS_BAR = 512 * 1024, WS_BAR_BYTES = 16384;
constexpr size_t WS_ADA = 0, WS_ROPE = 1 * MiB, WS_W = 2 * MiB, W_LAYER = 23 * MiB;
constexpr size_t WO_IN = 0, WO_OUT = 4 * MiB, WO_1 = 6 * MiB, WO_2 = 14 * MiB, WO_P = 22 * MiB;
constexpr size_t WS_X = 94 * MiB, WS_H = 162 * MiB, WS_Z = 196 * MiB, WS_MIX = 264 * MiB, WS_A = 196 * MiB, WS_PART = 332 * MiB, WS_END = 348 * MiB;
constexpr int LDS_BYTES = 147456, LDS_CTL = 143360;
constexpr int NWAVES = 8;

struct Params {
    const float *x, *c, *ctx, *c_ctx, *w_ada, *b_ada, *g_mix, *g_mlp, *w_in, *w_pool, *s_pool, *lq1, *lk1, *lq2, *lk2, *g_sub, *w_out, *w1, *w2, *g_final;
    float* out; unsigned char* ws;
};

__device__ __forceinline__ unsigned f2bf(float f) { unsigned u = __builtin_bit_cast(unsigned, f); return (u + 0x7fffu + ((u >> 16) & 1u)) >> 16; }
__device__ __forceinline__ unsigned pk2(float lo, float hi) { return f2bf(lo) | (f2bf(hi) << 16); }
__device__ __forceinline__ float bf2f(unsigned short v) { return __builtin_bit_cast(float, (unsigned)v << 16); }
__device__ __forceinline__ float shfl_xor_l(float v, int mask, int lane) { return __builtin_bit_cast(float, __builtin_amdgcn_ds_bpermute((lane ^ mask) << 2, __builtin_bit_cast(int, v))); }
__device__ __forceinline__ float wave_sum(float v, int lane) {
#pragma unroll
    for (int o = 1; o < 64; o <<= 1) v += shfl_xor_l(v, o, lane);
    return v;
}

__device__ __forceinline__ int inproj_dest(int n) { if (n < 512 || n >= 1536) return n; const int p = n & 63, nb = n - p; return nb + 2 * (p & 31) + (p >> 5); }
template <bool PERMQK>
__device__ __forceinline__ void transpose_item(const float* W, int K, int N, bf16* WT, LAS float* scr, int item, int lane) {
    const int nblk = N / 32, kb = item / nblk, nb = item % nblk, k0 = 64 * kb, n0 = 32 * nb;
    { const int kr = lane >> 3, c4 = lane & 7;
      f32x4 tv[8];
#pragma unroll
      for (int i = 0; i < 8; ++i) tv[i] = *(const f32x4*)(W + (size_t)(k0 + 8 * i + kr) * N + n0 + 4 * c4);
#pragma unroll
      for (int i = 0; i < 8; ++i) { LAS float* d = scr + (8 * i + kr) * 33 + 4 * c4; d[0] = tv[i].x; d[1] = tv[i].y; d[2] = tv[i].z; d[3] = tv[i].w; } }
    asm volatile("s_waitcnt lgkmcnt(0)" ::: "memory");
    const int c = lane & 7;
#pragma unroll
    for (int j = 0; j < 4; ++j) { const int n = (lane >> 3) + 8 * j; const LAS float* s = scr + (8 * c) * 33 + n;
        v4u o; o.x = pk2(s[0 * 33], s[1 * 33]); o.y = pk2(s[2 * 33], s[3 * 33]); o.z = pk2(s[4 * 33], s[5 * 33]); o.w = pk2(s[6 * 33], s[7 * 33]);
        const int nd = PERMQK ? inproj_dest(n0 + n) : (n0 + n);
        *(v4u*)(WT + (size_t)nd * K + k0 + 8 * c) = o; }
    asm volatile("s_waitcnt lgkmcnt(0)" ::: "memory");
}

__device__ __forceinline__ void prologue(const Params& p, LAS unsigned char* lds, int tid, int lane, int wid) {
    const int G = gridDim.x, bx = blockIdx.x;
    float* ada = (float*)(p.ws + WS_ADA);
    if (bx < 192) {
        LAS float* S = (LAS float*)lds;
        LAS float* P = (LAS float*)(lds + 20480);
        for (int idx = tid; idx < 5 * 1024; idx += 512) { const int r = idx >> 10, k = idx & 1023; const float v = (r < 4) ? p.c[r * 1024 + k] : p.c_ctx[k]; S[idx] = v / (1.f + __expf(-v)); }
        __syncthreads();
        for (int it = bx; it < 192; it += G) {
            const int l = it / 48, j0 = (it % 48) * 128;
            const float* wp = p.w_ada + ((size_t)l * 1024 + wid * 128) * NADA + j0 + 2 * lane;
            f32x2 a0 = {0.f, 0.f}, a1 = a0, a2 = a0, a3 = a0, a4 = a0;
#pragma unroll 16
            for (int k = 0; k < 128; ++k) { const f32x2 w = *(const f32x2*)(wp + (size_t)k * NADA); const int kk = wid * 128 + k;
                a0 += w * S[kk]; a1 += w * S[1024 + kk]; a2 += w * S[2048 + kk]; a3 += w * S[3072 + kk]; a4 += w * S[4096 + kk]; }
            LAS float* pw = P + wid * 640 + 2 * lane;
            *(LAS f32x2*)(pw) = a0; *(LAS f32x2*)(pw + 128) = a1; *(LAS f32x2*)(pw + 256) = a2; *(LAS f32x2*)(pw + 384) = a3; *(LAS f32x2*)(pw + 512) = a4;
            __syncthreads();
            for (int o = tid; o < 640; o += 512) { const int r = o >> 7, j = o & 127; float s = p.b_ada[l * NADA + j0 + j];
#pragma unroll
                for (int w = 0; w < 8; ++w) s += P[w * 640 + o];
                ada[((size_t)l * 5 + r) * NADA + j0 + j] = s; }
            __syncthreads();
        }
    }
    __syncthreads();
    {
        float* cosT = (float*)(p.ws + WS_ROPE); float* sinT = cosT + 4096 * 32;
        for (int idx = bx * 512 + tid; idx < 4096 * 32; idx += G * 512) { const int t = idx >> 5, i = idx & 31;
            const float inv = exp2f(-(float)(i & 15) * (13.287712379549449f / 16.0f));
            const float ang = (float)((i < 16) ? (t >> 6) : (t & 63)) * inv;
            cosT[idx] = __cosf(ang); sinT[idx] = __sinf(ang); }
    }
    {
        LAS float* scr = (LAS float*)(lds + wid * 16384);
        const int gw = bx * NWAVES + wid, NGW = G * NWAVES;
        constexpr int I_IN = 16 * 64, I_OUT = 16 * 32, I_1 = 16 * 128, I_2 = 64 * 32, I_P = 4 * 8, I_L = I_IN + I_OUT + I_1 + I_2 + I_P;
        for (int it = gw; it < NLAYER * I_L; it += NGW) {
            const int l = it / I_L; int r = it % I_L;
            unsigned char* wl = p.ws + WS_W + (size_t)l * W_LAYER;
            if (r < I_IN) { transpose_item<true>(p.w_in + (size_t)l * DM * INW, DM, INW, (bf16*)(wl + WO_IN), scr, r, lane); continue; } r -= I_IN;
            if (r < I_OUT) { transpose_item<false>(p.w_out + (size_t)l * DM * DM, DM, DM, (bf16*)(wl + WO_OUT), scr, r, lane); continue; } r -= I_OUT;
            if (r < I_1) { transpose_item<false>(p.w1 + (size_t)l * DM * DFF, DM, DFF, (bf16*)(wl + WO_1), scr, r, lane); continue; } r -= I_1;
            if (r < I_2) { transpose_item<false>(p.w2 + (size_t)l * DFF * DM, DFF, DM, (bf16*)(wl + WO_2), scr, r, lane); continue; } r -= I_2;
            { const int g = r >> 3; transpose_item<false>(p.w_pool + ((size_t)l * 4 + g) * 128 * 128, 128, 128, (bf16*)(wl + WO_P) + g * 16384, scr, r & 7, lane); }
        }
    }
}

#define NORM_ROWS_BEGIN() const int gw = blockIdx.x * NWAVES + wid, NGW = gridDim.x * NWAVES; \
    int q_ = 0; while ((q_ + 1) * NGW <= nrows) ++q_;                         \
    const int rem_ = nrows - q_ * NGW, r0 = gw * q_ + (gw < rem_ ? gw : rem_), r1 = r0 + q_ + (gw < rem_ ? 1 : 0)
#define NORM_LOAD_MOD(b_) do { const f32x4* gp_ = (const f32x4*)g + lane; const f32x4* sh_ = (const f32x4*)(adal + (size_t)(b_) * NADA + shift_idx * DM) + lane; \
        const f32x4* sc_ = (const f32x4*)(adal + (size_t)(b_) * NADA + (shift_idx + 1) * DM) + lane; \
        _Pragma("unroll") for (int j = 0; j < 4; ++j) { Gm[j] = gp_[64 * j] * (sc_[64 * j] + 1.0f); Sh[j] = sh_[64 * j]; } } while (0)
__device__ __forceinline__ void norm_mod_phase(const float* src_lat, const float* src_ctx, const float* g, const float* adal, int shift_idx, bf16* H, int nrows, int lane, int wid) {
    NORM_ROWS_BEGIN();
    int bcur = -1; f32x4 Gm[4], Sh[4];
    for (int row = r0; row < r1; ++row) {
        const bool lat = row < MLAT; const int b = lat ? (row >> 12) : 4;
        if (b != bcur) { NORM_LOAD_MOD(b); bcur = b; }
        const f32x4* xr = (const f32x4*)(lat ? src_lat + (size_t)row * DM : src_ctx + (size_t)(row - MLAT) * DM) + lane;
        f32x4 v[4]; float s = 0.f;
#pragma unroll
        for (int j = 0; j < 4; ++j) { v[j] = xr[64 * j]; s += (v[j].x * v[j].x + v[j].y * v[j].y) + (v[j].z * v[j].z + v[j].w * v[j].w); }
        const float rinv = 1.0f / sqrtf(wave_sum(s, lane) * (1.f / DM) + 1e-6f);
        unsigned long long* o8 = (unsigned long long*)(H + (size_t)row * DM) + lane;
#pragma unroll
        for (int j = 0; j < 4; ++j) { const f32x4 y = v[j] * rinv * Gm[j] + Sh[j];
            o8[64 * j] = (unsigned long long)pk2(y.x, y.y) | ((unsigned long long)pk2(y.z, y.w) << 32); }
    }
}
__device__ __forceinline__ f32x4 unpack4(v2u q) { return (f32x4){__builtin_bit_cast(float, q.x << 16), __builtin_bit_cast(float, q.x & 0xffff0000u), __builtin_bit_cast(float, q.y << 16), __builtin_bit_cast(float, q.y & 0xffff0000u)}; }
__device__ __forceinline__ void norm_mod_phase16(bf16* X16, const float* g, const float* adal, int shift_idx, bf16* H, int nrows, int lane, int wid, const float* part = nullptr, const float* pgate = nullptr) {
    NORM_ROWS_BEGIN();
    int bcur = -1; f32x4 Gm[4], Sh[4];
    for (int row = r0; row < r1; ++row) {
        const int b = row < MLAT ? (row >> 12) : 4;
        if (b != bcur) { NORM_LOAD_MOD(b); bcur = b; }
        const v2u* xr = (const v2u*)(X16 + (size_t)row * DM) + lane;
        f32x4 v[4]; float s = 0.f;
#pragma unroll
        for (int j = 0; j < 4; ++j) v[j] = unpack4(xr[64 * j]);
        if (part != nullptr && row >= MLAT) {
            const f32x4* pp = (const f32x4*)(part + (size_t)(row - MLAT) * DM) + lane; const f32x4* pg = (const f32x4*)pgate + lane;
#pragma unroll
            for (int j = 0; j < 4; ++j) { const f32x4 t = (pp[64 * j] + pp[64 * j + 262144]) + (pp[64 * j + 2 * 262144] + pp[64 * j + 3 * 262144]);
                v[j] += pg[64 * j] * t;
                v2u w; w.x = pk2(v[j].x, v[j].y); w.y = pk2(v[j].z, v[j].w); ((v2u*)(X16 + (size_t)row * DM) + lane)[64 * j] = w;
                v[j] = unpack4(w); }
        }
#pragma unroll
        for (int j = 0; j < 4; ++j) s += (v[j].x * v[j].x + v[j].y * v[j].y) + (v[j].z * v[j].z + v[j].w * v[j].w);
        const float rinv = 1.0f / sqrtf(wave_sum(s, lane) * (1.f / DM) + 1e-6f);
        unsigned long long* o8 = (unsigned long long*)(H + (size_t)row * DM) + lane;
#pragma unroll
        for (int j = 0; j < 4; ++j) { const f32x4 y = v[j] * rinv * Gm[j] + Sh[j];
            o8[64 * j] = (unsigned long long)pk2(y.x, y.y) | ((unsigned long long)pk2(y.z, y.w) << 32); }
    }
}
__device__ __forceinline__ void final_norm_phase(const bf16* X16, const float* g, float* out, int lane, int wid) {
    const int nrows = MLAT;
    NORM_ROWS_BEGIN();
    f32x4 Gm[4];
    { const f32x4* gp = (const f32x4*)g + lane;
#pragma unroll
      for (int j = 0; j < 4; ++j) Gm[j] = gp[64 * j]; }
    for (int row = r0; row < r1; ++row) {
        const v2u* xr = (const v2u*)(X16 + (size_t)row * DM) + lane;
        f32x4 v[4]; float s = 0.f;
#pragma unroll
        for (int j = 0; j < 4; ++j) { v[j] = unpack4(xr[64 * j]); s += (v[j].x * v[j].x + v[j].y * v[j].y) + (v[j].z * v[j].z + v[j].w * v[j].w); }
        const float rinv = 1.0f / sqrtf(wave_sum(s, lane) * (1.f / DM) + 1e-6f);
        f32x4* o = (f32x4*)(out + (size_t)row * DM) + lane;
#pragma unroll
        for (int j = 0; j < 4; ++j) o[64 * j] = v[j] * rinv * Gm[j];
    }
}
#undef NORM_ROWS_BEGIN
#undef NORM_LOAD_MOD

constexpr int POOL_PITCH = 1040;
__device__ __forceinline__ void pool_unit(LAS unsigned char* lds, const bf16* Z, bf16* MIX, const bf16* WpT, const float* spool, int tt, int tid, int lane, int wid) {
    const int row0 = tt * 64;
    int seq0, n; if (row0 < MLAT) { seq0 = row0 & ~4095; n = SEQ; } else { seq0 = MLAT + ((row0 - MLAT) & ~255); n = CTXL; }
    const int t0 = row0 - seq0;
    v4u uv[10];
#pragma unroll
    for (int i = 0; i < 10; ++i) { const int r = wid + 8 * i, tok = t0 - 8 + r; uv[i] = (v4u){0u, 0u, 0u, 0u};
        if (r < 79 && tok >= 0 && tok < n) uv[i] = *(const v4u*)(Z + (size_t)(seq0 + tok) * INW + lane * 8); }
    const int g = wid >> 1, dbase = (wid & 1) * 64, fr = lane & 15, fq = lane >> 4;
    bf16x8 af[4][4];
    { const bf16* Wg = WpT + g * 16384;
#pragma unroll
      for (int kk = 0; kk < 4; ++kk)
#pragma unroll
          for (int mi = 0; mi < 4; ++mi) af[kk][mi] = *(const bf16x8*)(Wg + (dbase + 16 * mi + fr) * 128 + 32 * kk + 8 * fq); }
#pragma unroll
    for (int i = 0; i < 10; ++i) { const int r = wid + 8 * i; if (r < 79) *(LAS v4u*)(lds + r * POOL_PITCH + lane * 16) = uv[i]; }
    __syncthreads();
    {
        const int cp = tid & 255, th = tid >> 8, gg = cp >> 6, w = 2 << gg, lo = w >> 1, hiw = (w >> 1) - 1;
        LAS unsigned* colw = (LAS unsigned*)lds + cp;
        constexpr int RW = POOL_PITCH / 4;
        const int ts = 32 * th;
        float s0 = 0.f, s1 = 0.f;
        for (int r = ts + 8 - lo; r <= ts + 8 + hiw; ++r) { const unsigned q = colw[r * RW]; s0 += __builtin_bit_cast(float, q << 16); s1 += __builtin_bit_cast(float, q & 0xffff0000u); }
        for (int i = 0; i < 32; ++i) { const int t = ts + i;
            const int tok = t0 + t; const int a = max(tok - lo, 0), e = min(tok + hiw, n - 1);
            const float rc = 1.0f / (float)(e - a + 1);
            const unsigned qo = colw[(t + 8 - lo) * RW], qi = colw[(t + 8) * RW];
            const float y0 = s0 * rc - __builtin_bit_cast(float, qi << 16), y1 = s1 * rc - __builtin_bit_cast(float, qi & 0xffff0000u);
            colw[(th ? 47 + t : t) * RW] = pk2(y0, y1);
            if (i < 31) { const unsigned qn = colw[(t + 9 + hiw) * RW];
                s0 += __builtin_bit_cast(float, qn << 16) - __builtin_bit_cast(float, qo << 16); s1 += __builtin_bit_cast(float, qn & 0xffff0000u) - __builtin_bit_cast(float, qo & 0xffff0000u); }
        }
    }
    __syncthreads();
    {
        f32x4 acc[4][4];
#pragma unroll
        for (int a = 0; a < 4; ++a)
#pragma unroll
            for (int b = 0; b < 4; ++b) acc[a][b] = (f32x4){0.f, 0.f, 0.f, 0.f};
#pragma unroll
        for (int kk = 0; kk < 4; ++kk) {
            bf16x8 bfr[4];
#pragma unroll
            for (int ni = 0; ni < 4; ++ni) { const int rowi = (ni < 2) ? 16 * ni + fr : 47 + 16 * ni + fr;
                bfr[ni] = *(const LAS bf16x8*)(lds + rowi * POOL_PITCH + (128 * g + 32 * kk + 8 * fq) * 2); }
#pragma unroll
            for (int mi = 0; mi < 4; ++mi)
#pragma unroll
                for (int ni = 0; ni < 4; ++ni) acc[mi][ni] = __builtin_amdgcn_mfma_f32_16x16x32_bf16(af[kk][mi], bfr[ni], acc[mi][ni], 0, 0, 0);
        }
#pragma unroll
        for (int mi = 0; mi < 4; ++mi) { const int d0 = dbase + 16 * mi + 4 * fq; const f32x4 sp = *(const f32x4*)(spool + 128 * g + d0);
#pragma unroll
            for (int ni = 0; ni < 4; ++ni) { const int t = 16 * ni + fr; const f32x4 v = acc[mi][ni] * sp;
                v2u w; w.x = pk2(v.x, v.y); w.y = pk2(v.z, v.w);
                *(v2u*)(MIX + (size_t)(row0 + t) * DM + 128 * g + d0) = w; } }
    }
    __syncthreads();
}

namespace att {
constexpr int BUF = 32768, K1_OFF = 0, K2_OFF = 8192, V_OFF = 16384, SCR_OFF = 4 * 32768;
__device__ __forceinline__ void glds16(const void* gsrc, unsigned lds_dst) { unsigned keep;
    asm volatile("s_mov_b32 %0, m0\n\ts_mov_b32 m0, %2\n\ts_nop 0\n\tglobal_load_lds_dwordx4 %1, off\n\ts_mov_b32 m0, %0" : "=&s"(keep) : "v"(gsrc), "s"(lds_dst) : "memory"); }
typedef short v4i16_t __attribute__((ext_vector_type(4)));
__device__ __forceinline__ int crow(int r, int hi) { return (r & 3) + 8 * (r >> 2) + 4 * hi; }
__device__ __forceinline__ bf16x8 pack8(const f32x16& x, int s) {
    typedef __bf16 bf16x2_t __attribute__((ext_vector_type(2)));
    v4u p;
#pragma unroll
    for (int j = 0; j < 4; ++j) { f32x2 v = {x[8 * s + 2 * j], x[8 * s + 2 * j + 1]}; bf16x2_t b = __builtin_convertvector(v, bf16x2_t); p[j] = __builtin_bit_cast(unsigned, b); }
    return __builtin_bit_cast(bf16x8, p);
}
__device__ __forceinline__ int tile_row(bool latent, int b, int t) { return latent ? (t < 4 ? MLAT + b * CTXL + 64 * t : b * SEQ + 64 * (t - 4)) : (MLAT + b * CTXL + 64 * t); }

__device__ __forceinline__ void attn_unit(LAS unsigned char* lds, const bf16* Z, bf16* MIX, int b, int h, int qrow0, int NT, bool latent, float lam, float oscale, const float* gsub, int tid, int lane, int wid) {
    const int r32 = lane & 31, hi = lane >> 5, qg = wid >> 1, s = wid & 1;
    const unsigned lds0 = (unsigned)(uintptr_t)lds;
    const int kkey = 8 * wid + (lane >> 3), kcs = (lane & 7) ^ ((kkey >> 1) & 7);
    const int ksrc = kkey * INW + 1024 + (2 * h) * 64 + kcs * 8;
    const int pc0 = wid, pc1 = wid + 8;
    const int vsrc0 = (16 * (pc0 & 3) + (lane >> 2)) * INW + 1536 + h * 128 + (pc0 >> 2) * 32 + (lane & 3) * 8;
    const int vsrc1 = (16 * (pc1 & 3) + (lane >> 2)) * INW + 1536 + h * 128 + (pc1 >> 2) * 32 + (lane & 3) * 8;
#define ATT_DMA(t, bo_) do { const bf16* base_ = Z + (size_t)tile_row(latent, b, (t)) * INW; const unsigned d_ = lds0 + (unsigned)(bo_); \
        glds16(base_ + ksrc, (unsigned)__builtin_amdgcn_readfirstlane(d_ + K1_OFF + wid * 1024)); glds16(base_ + ksrc + 64, (unsigned)__builtin_amdgcn_readfirstlane(d_ + K2_OFF + wid * 1024)); \
        glds16(base_ + vsrc0, (unsigned)__builtin_amdgcn_readfirstlane(d_ + V_OFF + pc0 * 1024)); glds16(base_ + vsrc1, (unsigned)__builtin_amdgcn_readfirstlane(d_ + V_OFF + pc1 * 1024)); } while (0)
#define ATT_WAIT_BAR(N) asm volatile("s_waitcnt vmcnt(" #N ") lgkmcnt(0)\n\ts_barrier" ::: "memory")
    ATT_DMA(0, 0); ATT_DMA(1, BUF); ATT_DMA(2, 2 * BUF);
    bf16x8 qr[4];
    { const bf16* Qp = Z + (size_t)(qrow0 + qg * 32 + r32) * INW + 512 + (2 * h + s) * 64 + hi * 8;
#pragma unroll
      for (int d0 = 0; d0 < 4; ++d0) qr[d0] = *(const bf16x8*)(Qp + d0 * 16); }
    asm volatile("" : "+v"(qr[0]), "+v"(qr[1]), "+v"(qr[2]), "+v"(qr[3]));
    ATT_WAIT_BAR(0);
    float m = 0.f, l = 0.f;
    f32x16 o[4];
#pragma unroll
    for (int d0 = 0; d0 < 4; ++d0)
#pragma unroll
        for (int i = 0; i < 16; ++i) o[d0][i] = 0.f;
    LAS float* scr = (LAS float*)(lds + SCR_OFF) + wid * 64;
    const int kbase = s ? K2_OFF : K1_OFF;
    const int vlane = (4 * hi + ((lane & 15) >> 2)) * 64 + ((lane >> 4) & 1) * 32 + (lane & 3) * 8;
    const int klane = kbase + r32 * 128;
    const int ksw = (r32 >> 1) & 7;
#define ATT_TR(p_) __builtin_bit_cast(s16x4, __builtin_amdgcn_ds_read_tr16_b64_v4i16((LAS v4i16_t*)(p_)))
#define ATT_VF(a_, i_) ((bf16x8){a_[2 * (i_)][0], a_[2 * (i_)][1], a_[2 * (i_)][2], a_[2 * (i_)][3], a_[2 * (i_) + 1][0], a_[2 * (i_) + 1][1], a_[2 * (i_) + 1][2], a_[2 * (i_) + 1][3]})
#define ATT_KLOAD(bo_) do { _Pragma("unroll") for (int d0 = 0; d0 < 4; ++d0) { const LAS unsigned char* ka = lds + (bo_) + klane + (((2 * d0 + hi) ^ ksw) * 16); \
            kf[2 * d0] = *(const LAS bf16x8*)ka; kf[2 * d0 + 1] = *(const LAS bf16x8*)(ka + 4096); } } while (0)
#define ATT_VLOAD(dst_, ks_) do { _Pragma("unroll") for (int d0 = 0; d0 < 4; ++d0) { const LAS unsigned char* vp = lds + bo + V_OFF + d0 * 4096 + (ks_) * 1024 + vlane; \
            dst_[d0 * 2] = ATT_TR(vp); dst_[d0 * 2 + 1] = ATT_TR(vp + 512); } } while (0)
#define ATT_PV(src_, ks_) do { _Pragma("unroll") for (int d0 = 0; d0 < 4; ++d0) o[d0] = __builtin_amdgcn_mfma_f32_32x32x16_bf16(pa[ks_], ATT_VF(src_, d0), o[d0], 0, 0, 0); } while (0)
#define ATT_QK(P0_, P1_) do { _Pragma("unroll") for (int i = 0; i < 16; ++i) { P0_[i] = 0.f; P1_[i] = 0.f; } \
        _Pragma("unroll") for (int d0 = 0; d0 < 4; ++d0) { P0_ = __builtin_amdgcn_mfma_f32_32x32x16_bf16(kf[2 * d0], qr[d0], P0_, 0, 0, 0); P1_ = __builtin_amdgcn_mfma_f32_32x32x16_bf16(kf[2 * d0 + 1], qr[d0], P1_, 0, 0, 0); } } while (0)
    f32x16 p0, p1;
#define ATT_ROWMAX(P0_, P1_, OUT_) do { float rm_ = fmaxf(P0_[0], P1_[0]); _Pragma("unroll") for (int i = 1; i < 16; ++i) rm_ = fmaxf(rm_, fmaxf(P0_[i], P1_[i])); OUT_ = fmaxf(rm_, shfl_xor_l(rm_, 32, lane)); } while (0)
    { bf16x8 kf[8]; ATT_KLOAD(0); ATT_QK(p0, p1); }
    float rm; ATT_ROWMAX(p0, p1, rm);
    int bo = 0, bo1 = BUF, bo2 = 2 * BUF, bo3 = 3 * BUF;
    for (int t = 0; t < NT; ++t) {
        if (t + 3 < NT) ATT_DMA(t + 3, bo3);
        bf16x8 kf[8]; ATT_KLOAD(bo1);
        s16x4 va[8], vb[8];
        ATT_VLOAD(va, 0);
        __builtin_amdgcn_sched_barrier(0);
        const bool first = (t == 0);
        if (first || __any(rm > 8.0f)) {
            const float dl = first ? rm : fmaxf(rm, 0.f);
            const float al = __builtin_amdgcn_exp2f(-dl);
            m += dl; l *= al;
#pragma unroll
            for (int i = 0; i < 16; ++i) { p0[i] -= dl; p1[i] -= dl; }
            if (hi == 0) scr[r32] = al;
            __builtin_amdgcn_wave_barrier();
#pragma unroll
            for (int i = 0; i < 16; ++i) { const float a = scr[crow(i, hi)];
#pragma unroll
                for (int d0 = 0; d0 < 4; ++d0) o[d0][i] *= a; }
            __builtin_amdgcn_wave_barrier();
        }
        __builtin_amdgcn_sched_barrier(0);
        f32x16 n0, n1;
        ATT_QK(n0, n1);
        f32x2 sacc = {0.f, 0.f};
#pragma unroll
        for (int i = 0; i < 16; i += 2) { p0[i] = __builtin_amdgcn_exp2f(p0[i]); p0[i + 1] = __builtin_amdgcn_exp2f(p0[i + 1]); sacc += (f32x2){p0[i], p0[i + 1]}; }
        bf16x8 pa[4]; pa[0] = pack8(p0, 0); pa[1] = pack8(p0, 1);
        __builtin_amdgcn_sched_barrier(0);
        ATT_VLOAD(vb, 1);
        ATT_PV(va, 0);
#pragma unroll
        for (int i = 0; i < 16; i += 2) { p1[i] = __builtin_amdgcn_exp2f(p1[i]); p1[i + 1] = __builtin_amdgcn_exp2f(p1[i + 1]); sacc += (f32x2){p1[i], p1[i + 1]}; }
        pa[2] = pack8(p1, 0); pa[3] = pack8(p1, 1);
        l += sacc.x + sacc.y;
        __builtin_amdgcn_sched_barrier(0);
        ATT_VLOAD(va, 2);
        __builtin_amdgcn_sched_barrier(0);
        ATT_PV(vb, 1);
        __builtin_amdgcn_sched_barrier(0);
        ATT_VLOAD(vb, 3);
        __builtin_amdgcn_sched_barrier(0);
        ATT_PV(va, 2);
        { const f32x2 nm2 = {-m, -m};
          _Pragma("unroll") for (int i = 0; i < 16; i += 2) { f32x2 a = {n0[i], n0[i + 1]}, c2 = {n1[i], n1[i + 1]}; a += nm2; c2 += nm2; n0[i] = a.x; n0[i + 1] = a.y; n1[i] = c2.x; n1[i + 1] = c2.y; } }
        ATT_PV(vb, 3);
        ATT_ROWMAX(n0, n1, rm);
        if (t + 3 < NT) ATT_WAIT_BAR(4); else ATT_WAIT_BAR(0);
        p0 = n0; p1 = n1;
        { const int tmp_ = bo; bo = bo1; bo1 = bo2; bo2 = bo3; bo3 = tmp_; }
    }
#undef ATT_ROWMAX
#undef ATT_KLOAD
#undef ATT_VLOAD
#undef ATT_PV
#undef ATT_QK
#undef ATT_TR
#undef ATT_VF
#undef ATT_DMA
#undef ATT_WAIT_BAR
    l += shfl_xor_l(l, 32, lane);
    if (hi == 0) scr[32 + r32] = 1.0f / l;
    __builtin_amdgcn_wave_barrier();
#pragma unroll
    for (int i = 0; i < 16; ++i) { const float a = scr[32 + crow(i, hi)];
#pragma unroll
        for (int d0 = 0; d0 < 4; ++d0) o[d0][i] *= a; }
    LAS float* ex = (LAS float*)lds + qg * 4096 + lane;
    if (s == 1) {
#pragma unroll
        for (int d0 = 0; d0 < 4; ++d0)
#pragma unroll
            for (int i = 0; i < 16; ++i) ex[(d0 * 16 + i) * 64] = o[d0][i];
    }
    __syncthreads();
    if (s == 0) {
        float ssq[16];
#pragma unroll
        for (int i = 0; i < 16; ++i) { float q = 0.f;
#pragma unroll
            for (int d0 = 0; d0 < 4; ++d0) { const float v = o[d0][i] - lam * ex[(d0 * 16 + i) * 64]; o[d0][i] = v; q += v * v; }
            ssq[i] = q; }
#define ATT_DPP_ROR(v_, n_) __builtin_bit_cast(float, __builtin_amdgcn_update_dpp(0, __builtin_bit_cast(int, (v_)), 0x120 + (n_), 0xf, 0xf, false))
#pragma unroll
        for (int i = 0; i < 16; ++i) { float v = ssq[i];
            v += ATT_DPP_ROR(v, 8); v += ATT_DPP_ROR(v, 4); v += ATT_DPP_ROR(v, 2); v += ATT_DPP_ROR(v, 1);
            ssq[i] = v + shfl_xor_l(v, 16, lane); }
#undef ATT_DPP_ROR
        float gs[4];
#pragma unroll
        for (int d0 = 0; d0 < 4; ++d0) gs[d0] = gsub[32 * d0 + r32] * oscale;
#pragma unroll
        for (int i = 0; i < 16; ++i) { const float rn = 1.0f / sqrtf(ssq[i] * (1.0f / 128.0f) + 1e-6f);
            bf16* op = MIX + (size_t)(qrow0 + qg * 32 + crow(i, hi)) * DM + 512 + h * 128 + r32;
#pragma unroll
            for (int d0 = 0; d0 < 4; ++d0) op[32 * d0] = (bf16)f2bf(o[d0][i] * rn * gs[d0]); }
    }
    __syncthreads();
}
}

namespace sg {
struct EpiZ {
    bf16* Z;
    __device__ __forceinline__ void operator()(int r, int c, const f32x4& a, int) const { const float sc = (c >= 512 && c < 1024) ? 0.18033688011112042f : 1.0f;
        v2u w; w.x = pk2(a.x * sc, a.y * sc); w.y = pk2(a.z * sc, a.w * sc); *(v2u*)(Z + (size_t)r * INW + c) = w; }
};
struct EpiSq {
    bf16* O;
    __device__ __forceinline__ void operator()(int r, int c, const f32x4& a, int) const { const float x = fmaxf(a.x, 0.f), y = fmaxf(a.y, 0.f), z = fmaxf(a.z, 0.f), w_ = fmaxf(a.w, 0.f);
        v2u w; w.x = pk2(x * x, y * y); w.y = pk2(z * z, w_ * w_); *(v2u*)(O + (size_t)r * DFF + c) = w; }
};
struct EpiR {
    const float* res32; const bf16* res16; bf16* out16; const float* gate;
    __device__ __forceinline__ void operator()(int r, int c, const f32x4& a, int) const { const f32x4 g = *(const f32x4*)(gate + c); f32x4 x;
        if (res16) { const v2u q = *(const v2u*)(res16 + (size_t)r * DM + c);
            x = (f32x4){__builtin_bit_cast(float, q.x << 16), __builtin_bit_cast(float, q.x & 0xffff0000u), __builtin_bit_cast(float, q.y << 16), __builtin_bit_cast(float, q.y & 0xffff0000u)}; }
        else x = *(const f32x4*)(res32 + (size_t)r * DM + c);
        const f32x4 o = x + g * a;
        v2u w; w.x = pk2(o.x, o.y); w.y = pk2(o.z, o.w); *(v2u*)(out16 + (size_t)r * DM + c) = w; }
};
struct EpiPart {
    float* P;
    __device__ __forceinline__ void operator()(int r, int c, const f32x4& a, int ks) const { *(f32x4*)(P + ((size_t)ks * 1024 + r) * DM + c) = a; }
};
template <int BN, class Epi, int BM = 64>
__device__ __forceinline__ void small_gemm(LAS unsigned char* lds, const bf16* A, const bf16* Bt, int M, int N, int K, const Epi& E, int tid, int lane, int wid, int KS = 1) {
    constexpr int BK = 128, MT = BM / 32, NTN = BN / 64, NAL = BM / 32, NBL = BN / 32, ABYTES = BM * BK * 2, BBYTES = BN * BK * 2, STAGE = ABYTES + BBYTES;
    const int nN = N / BN, nitems = (M / BM) * nN * KS, Kc = K / KS, nk = Kc / BK;
    const int wm = wid >> 2, wn = wid & 3, fr = lane & 15, fq = lane >> 4;
    const int srow = tid >> 4, sch = tid & 15;
    for (int item = blockIdx.x; item < nitems; item += gridDim.x) {
        const int ks = item % KS, tile = item / KS, pm = tile / nN, pn = tile % nN;
        const bf16* Ag = A + (size_t)(pm * BM + srow) * K + ks * Kc + sch * 8; const bf16* Bg = Bt + (size_t)(pn * BN + srow) * K + ks * Kc + sch * 8;
        f32x4 acc[MT][NTN];
#pragma unroll
        for (int m = 0; m < MT; ++m)
#pragma unroll
            for (int n = 0; n < NTN; ++n) acc[m][n] = (f32x4){0.f, 0.f, 0.f, 0.f};
        v4u ra[NAL], rb[NBL], ra2[NAL], rb2[NBL];
#define SG_LOAD(A_, B_, kt_) do { _Pragma("unroll") for (int j = 0; j < NAL; ++j) A_[j] = *(const v4u*)(Ag + (size_t)(32 * j) * K + (kt_) * BK); \
                          _Pragma("unroll") for (int j = 0; j < NBL; ++j) B_[j] = *(const v4u*)(Bg + (size_t)(32 * j) * K + (kt_) * BK); } while (0)
#define SG_STORE(A_, B_, b_) do { _Pragma("unroll") for (int j = 0; j < NAL; ++j) { const int r_ = srow + 32 * j; *(LAS v4u*)(lds + (b_) * STAGE + r_ * 256 + ((sch ^ (r_ & 15)) * 16)) = A_[j]; } \
                          _Pragma("unroll") for (int j = 0; j < NBL; ++j) { const int r_ = srow + 32 * j; *(LAS v4u*)(lds + (b_) * STAGE + ABYTES + r_ * 256 + ((sch ^ (r_ & 15)) * 16)) = B_[j]; } } while (0)
#define SG_COMPUTE(b_) do { const LAS unsigned char* sa = lds + (b_) * STAGE; const LAS unsigned char* sb = sa + ABYTES; \
            _Pragma("unroll") for (int kk = 0; kk < 4; ++kk) { bf16x8 af[MT], bfr[NTN]; \
                _Pragma("unroll") for (int m = 0; m < MT; ++m) { const int r_ = (BM / 2) * wm + 16 * m + fr; af[m] = *(const LAS bf16x8*)(sa + r_ * 256 + (((kk * 4 + fq) ^ (r_ & 15)) * 16)); } \
                _Pragma("unroll") for (int n = 0; n < NTN; ++n) { const int r_ = (BN / 4) * wn + 16 * n + fr; bfr[n] = *(const LAS bf16x8*)(sb + r_ * 256 + (((kk * 4 + fq) ^ (r_ & 15)) * 16)); } \
                _Pragma("unroll") for (int m = 0; m < MT; ++m) _Pragma("unroll") for (int n = 0; n < NTN; ++n) acc[m][n] = __builtin_amdgcn_mfma_f32_16x16x32_bf16(bfr[n], af[m], acc[m][n], 0, 0, 0); } } while (0)
        SG_LOAD(ra, rb, 0); SG_LOAD(ra2, rb2, 1); SG_STORE(ra, rb, 0);
        __syncthreads();
        for (int kt = 0; kt < nk; kt += 2) {
            if (kt + 2 < nk) SG_LOAD(ra, rb, kt + 2);
            SG_COMPUTE(0);
            SG_STORE(ra2, rb2, 1);
            __syncthreads();
            if (kt + 3 < nk) SG_LOAD(ra2, rb2, kt + 3);
            SG_COMPUTE(1);
            if (kt + 2 < nk) SG_STORE(ra, rb, 0);
            __syncthreads();
        }
#undef SG_COMPUTE
#undef SG_LOAD
#undef SG_STORE
#pragma unroll
        for (int m = 0; m < MT; ++m)
#pragma unroll
            for (int n = 0; n < NTN; ++n) E(pm * BM + (BM / 2) * wm + 16 * m + fr, pn * BN + (BN / 4) * wn + 16 * n + 4 * fq, acc[m][n], ks);
    }
}
}

#define XB_TMO      128
#define XB_XCNT(j)  (256  + 64 * (j))
#define XB_XSUB(j)  (1280 + 64 * (j))
#define XB_XGEN(j)  (2304 + 64 * (j))
#define XB_TOP      3328
#define XB_TOPGEN   3392
#define XCD_BAR_WORDS 3456
#define XB_SPIN_CAP (1u << 18)

__device__ __forceinline__ unsigned xb_ld(unsigned* p)              { return __hip_atomic_load(p, __ATOMIC_RELAXED, __HIP_MEMORY_SCOPE_AGENT); }
__device__ __forceinline__ unsigned xb_add(unsigned* p, unsigned v) { return __hip_atomic_fetch_add(p, v, __ATOMIC_RELAXED, __HIP_MEMORY_SCOPE_AGENT); }
__device__ __forceinline__ unsigned xb_xcc_id() { return (unsigned)__builtin_amdgcn_s_getreg((3 << 11) | 20) & 0xFu; }
#define XB_SPIN(cond, bar) do { unsigned _sp = 0; while (cond) { __builtin_amdgcn_s_sleep(1); \
    if ((++_sp & 255u) == 0u) { if (xb_ld(&(bar)[XB_TMO])) break; if (_sp > XB_SPIN_CAP) { atomicAdd(&(bar)[XB_TMO], 1u); break; } } } } while (0)

struct XcdBarrier {
    unsigned* bar; unsigned x;
    volatile LAS unsigned* st;
};

__device__ __forceinline__ XcdBarrier xcd_barrier_post(unsigned* bar, volatile LAS unsigned* st) {
    XcdBarrier b; b.bar = bar; b.x = (unsigned)__builtin_amdgcn_readfirstlane((int)xb_xcc_id()); b.st = st;
    if (threadIdx.x == 0) (void)xb_add(&bar[XB_XCNT(b.x)], 1u);
    return b;
}
__device__ __forceinline__ void xcd_barrier_complete(unsigned* bar, unsigned x, unsigned& nloc, unsigned& nx) {
    const unsigned G = gridDim.x * gridDim.y * gridDim.z;
    unsigned sum, cnt, mine, sp = 0u;
    for (;;) {
        sum = 0u; cnt = 0u; mine = 0u;
#pragma unroll
        for (unsigned j = 0; j < 16; ++j) { const unsigned c = xb_ld(&bar[XB_XCNT(j)]); sum += c; cnt += (c > 0u) ? 1u : 0u; mine = (j == x) ? c : mine; }
        if (sum == G) break;
        __builtin_amdgcn_s_sleep(1);
        if ((++sp & 255u) == 0u) { if (xb_ld(&bar[XB_TMO])) break; if (sp > XB_SPIN_CAP) { atomicAdd(&bar[XB_TMO], 1u); break; } }
    }
    nloc = mine > 0u ? mine : 1u; nx = cnt > 0u ? cnt : 1u;
}

__device__ __forceinline__ void xcd_barrier(const XcdBarrier& b) {
    asm volatile("s_waitcnt vmcnt(0)" ::: "memory");
    __syncthreads();
    if (threadIdx.x == 0) {
        unsigned* bar = b.bar;
        unsigned bx_ = b.x; asm volatile("" : "+s"(bx_));
        __builtin_amdgcn_s_waitcnt(0);
        unsigned nloc = b.st[0], nx = b.st[1];
        if (nloc == 0u) { xcd_barrier_complete(bar, bx_, nloc, nx); b.st[0] = nloc; b.st[1] = nx; }
        const unsigned old = xb_add(&bar[XB_XSUB(bx_)], 1u);
        const unsigned gen = old / nloc;
        if (old + 1u == (gen + 1u) * nloc) {
            __builtin_amdgcn_fence(__ATOMIC_RELEASE, "agent");
            asm volatile("s_waitcnt vmcnt(0)" ::: "memory");
            const unsigned og = xb_add(&bar[XB_TOP], 1u);
            const unsigned tg = og / nx;
            if (og + 1u == (tg + 1u) * nx) xb_add(&bar[XB_TOPGEN], 1u);
            else XB_SPIN(xb_ld(&bar[XB_TOPGEN]) == tg, bar);
            __builtin_amdgcn_fence(__ATOMIC_ACQUIRE, "agent");
            xb_add(&bar[XB_XGEN(bx_)], 1u);
            asm volatile("s_waitcnt vmcnt(0)" ::: "memory");
        } else {
            XB_SPIN(xb_ld(&bar[XB_XGEN(bx_)]) == gen, bar);
            __builtin_amdgcn_fence(__ATOMIC_ACQUIRE, "agent");
            asm volatile("s_waitcnt vmcnt(0)" ::: "memory");
        }
    }
    __syncthreads();
}

__global__ void __launch_bounds__(512, 2) mega_fwd(Params p) {
    extern __shared__ __attribute__((aligned(16))) unsigned char lds_raw[];
    LAS unsigned char* lds = (LAS unsigned char*)lds_raw;
    cg::grid_group grid = cg::this_grid();
    int tid = threadIdx.x, lane = tid & 63, wid = __builtin_amdgcn_readfirstlane(tid >> 6);
#define OPAQUE_TID() do { tid = threadIdx.x; asm volatile("" : "+v"(tid)); lane = tid & 63; wid = __builtin_amdgcn_readfirstlane(tid >> 6); } while (0)
    const int G = gridDim.x, bx = blockIdx.x;
    const int vcu = (G % 8 == 0) ? (bx % 8) * (G / 8) + bx / 8 : bx;
    unsigned char* ws = p.ws;
    if (tid < 16) ((LAS unsigned*)(lds + LDS_CTL))[tid] = 0u;
    __syncthreads();
    const XcdBarrier xbar = xcd_barrier_post((unsigned*)(ws + WS_BAR), (volatile LAS unsigned*)(lds + LDS_CTL));
    float* ada = (float*)(ws + WS_ADA);
    const float* cosT = (const float*)(ws + WS_ROPE); const float* sinT = cosT + 4096 * 32;
    bf16* X16 = (bf16*)(ws + WS_X);
    bf16* H = (bf16*)(ws + WS_H); bf16* Z = (bf16*)(ws + WS_Z); bf16* MIX = (bf16*)(ws + WS_MIX); bf16* A = (bf16*)(ws + WS_A);

#ifndef NO_PRO
    for (int rep_ = 0; rep_ < REP_N; ++rep_) { prologue(p, lds, tid, lane, wid); __syncthreads(); }
#endif
    if (ws == nullptr) grid.sync();
    xcd_barrier(xbar);

    for (int l = 0; l < NLAYER; ++l) {
        const bool last = (l == NLAYER - 1);
        const int rows2 = last ? MLAT : MTOT;
        const unsigned char* wl = ws + WS_W + (size_t)l * W_LAYER;
        const float* adal = ada + (size_t)l * 5 * NADA;
        const bool l0 = (l == 0);

        OPAQUE_TID();
        if (l0) norm_mod_phase(p.x, p.ctx, p.g_mix + l * DM, adal, 0, H, MTOT, lane, wid);
        else norm_mod_phase16(X16, p.g_mix + l * DM, adal, 0, H, MTOT, lane, wid, (const float*)(ws + WS_PART), ada + ((size_t)(l - 1) * 5 + 4) * NADA + 5 * DM);
        GSYNC();
        { pg8::Gemm g{H, (const bf16*)(wl + WO_IN), MLAT, INW, DM}; pg8::StaticOrder S; S.init(MLAT, INW, G, bx);
          pg8::EpiInProj E{Z, cosT, sinT};
          for (int rep_ = 0; rep_ < REP_G; ++rep_) pg8::gemm_phase<pg8::EpiInProj, pg8::StaticOrder, true, true>(lds, g, S, E); }
        { OPAQUE_TID(); sg::EpiZ E{Z + (size_t)MLAT * INW};
          sg::small_gemm<128, sg::EpiZ>(lds, H + (size_t)MLAT * DM, (const bf16*)(wl + WO_IN), MTOT - MLAT, INW, DM, E, tid, lane, wid); }
        GSYNC();
        OPAQUE_TID();
        {
            float lam, lam_init = 0.8f - 0.6f * __expf(-0.3f * (float)l);
            { const float a = p.lq1[l * 64 + lane] * p.lk1[l * 64 + lane], c2 = p.lq2[l * 64 + lane] * p.lk2[l * 64 + lane];
              lam = __expf(wave_sum(a, lane)) - __expf(wave_sum(c2, lane)) + lam_init; }
            const float oscale = 1.0f - lam_init;
            const float* gsub = p.g_sub + l * 128;
            _Pragma("nounroll") for (int rep_ = 0; rep_ < REP_ATT; ++rep_) {
            const int natt = last ? 512 : 544;
            _Pragma("nounroll") for (int u = vcu; u < natt; u += G) {
                OPAQUE_TID();
                int b, h, qrow0, NT; bool latent;
                if (u < 512) { const int bh = u >> 5, qb = u & 31; b = bh >> 2; h = bh & 3; qrow0 = b * SEQ + qb * 128; NT = 68; latent = true; }
                else { const int v = u - 512, bh = v >> 1, qb = v & 1; b = bh >> 2; h = bh & 3; qrow0 = MLAT + b * CTXL + qb * 128; NT = 4; latent = false; }
                att::attn_unit(lds, Z, MIX, b, h, qrow0, NT, latent, lam, oscale, gsub, tid, lane, wid);
            }
            const int nctx = last ? 0 : 32, NE = nctx + (last ? 256 : 272);
            _Pragma("nounroll") for (int r = 0; r * G < NE; ++r) { const int e = r * G + ((r & 1) ? G - 1 - vcu : vcu);
                if (e >= nctx && e < NE) { OPAQUE_TID(); pool_unit(lds, Z, MIX, (const bf16*)(wl + WO_P), p.s_pool + l * 512, e - nctx, tid, lane, wid); } }
            }
        }
        GSYNC();
        { pg8::Gemm g{MIX, (const bf16*)(wl + WO_OUT), MLAT, DM, DM}; pg8::StaticOrder S; S.init(MLAT, DM, G, bx);
          pg8::EpiRes E{p.x, p.ctx, l0 ? (const bf16*)nullptr : (const bf16*)X16, X16, adal + 2 * DM};
          pg8::gemm_phase<pg8::EpiRes, pg8::StaticOrder, true, true>(lds, g, S, E); }
        if (!last) { OPAQUE_TID(); sg::EpiR E{p.ctx, l0 ? (const bf16*)nullptr : (const bf16*)(X16 + (size_t)MLAT * DM), X16 + (size_t)MLAT * DM, adal + 4 * NADA + 2 * DM};
          sg::small_gemm<64, sg::EpiR>(lds, MIX + (size_t)MLAT * DM, (const bf16*)(wl + WO_OUT), MTOT - MLAT, DM, DM, E, tid, lane, wid); }
        GSYNC();
        OPAQUE_TID();
        norm_mod_phase16(X16, p.g_mlp + l * DM, adal, 3, H, rows2, lane, wid);
        GSYNC();
        { pg8::Gemm g{H, (const bf16*)(wl + WO_1), MLAT, DFF, DM}; pg8::StaticOrder S; S.init(MLAT, DFF, G, bx);
          pg8::EpiSqRelu E{A, DFF};
          for (int rep_ = 0; rep_ < REP_G; ++rep_) pg8::gemm_phase<pg8::EpiSqRelu, pg8::StaticOrder, true, true>(lds, g, S, E); }
        if (!last) { OPAQUE_TID(); sg::EpiSq E{A + (size_t)MLAT * DFF};
          sg::small_gemm<128, sg::EpiSq, 128>(lds, H + (size_t)MLAT * DM, (const bf16*)(wl + WO_1), MTOT - MLAT, DFF, DM, E, tid, lane, wid); }
        GSYNC();
        { pg8::Gemm g{A, (const bf16*)(wl + WO_2), MLAT, DM, DFF}; pg8::StaticOrder S; S.init(MLAT, DM, G, bx);
          pg8::EpiRes E{p.x, p.ctx, X16, X16, adal + 5 * DM};
          pg8::gemm_phase<pg8::EpiRes, pg8::StaticOrder, true, true>(lds, g, S, E); }
        if (!last) { OPAQUE_TID(); sg::EpiPart E{(float*)(ws + WS_PART)};
          sg::small_gemm<128, sg::EpiPart, 128>(lds, A + (size_t)MLAT * DFF, (const bf16*)(wl + WO_2), MTOT - MLAT, DM, DFF, E, tid, lane, wid, 4); }
        GSYNC();
    }
    OPAQUE_TID();
    final_norm_phase(X16, p.g_final, p.out, lane, wid);
}

extern "C" void kernel_launch(void* const* d_in, const int* in_sizes, int n_in, void* d_out, int out_size, void* d_ws, size_t ws_size, hipStream_t stream) {
    static int grid = 0;
    if (grid == 0) {
        if (n_in != 20 || ws_size < WS_END) { fprintf(stderr, "kernel_launch: unexpected n_in %d or ws_size %zu (< %zu)\n", n_in, ws_size, (size_t)WS_END); }
        int dev = 0, cus = 0, per_cu = 0;
        (void)hipGetDevice(&dev);
        (void)hipDeviceGetAttribute(&cus, hipDeviceAttributeMultiprocessorCount, dev);
        (void)hipFuncSetAttribute((const void*)mega_fwd, hipFuncAttributeMaxDynamicSharedMemorySize, LDS_BYTES);
        (void)hipOccupancyMaxActiveBlocksPerMultiprocessor(&per_cu, (const void*)mega_fwd, 512, LDS_BYTES);
        if (per_cu < 1) per_cu = 1;
        grid = cus * per_cu;
        fprintf(stderr, "kernel_launch: grid %d (cus %d x %d)\n", grid, cus, per_cu);
    }
    (void)hipMemsetAsync((unsigned char*)d_ws + WS_BAR, 0, WS_BAR_BYTES, stream);
    Params p{};
    const float** pp = (const float**)&p;
    for (int i = 0; i < 20; ++i) pp[i] = (const float*)d_in[i];
    p.out = (float*)d_out; p.ws = (unsigned char*)d_ws;
    void* args[] = {&p};
    hipError_t e = hipLaunchCooperativeKernel((const void*)mega_fwd, dim3(grid), dim3(512), args, LDS_BYTES, stream);
    if (e != hipSuccess) fprintf(stderr, "cooperative launch failed: %s (grid %d)\n", hipGetErrorString(e), grid);
}
```

```cpp
#include <hip/hip_runtime.h>
#include <hip/hip_cooperative_groups.h>
#include <hip/hip_bf16.h>
#include <cstdio>
#include <cstdint>
namespace cg = cooperative_groups;
#ifndef REP_ATT
#define REP_ATT 1
#endif
#ifndef REP_G
#define REP_G 1
#endif
#ifndef REP_N
#define REP_N 1
#endif
#ifndef REP_SYNC
#define REP_SYNC 1
#endif
#define GSYNC() do { for (int r_ = 0; r_ < REP_SYNC; ++r_) xcd_barrier(xbar); } while (0)
namespace pg8 {
#define PG8_LAS __attribute__((address_space(3)))
typedef unsigned short bf16_t;
typedef short bf16x8 __attribute__((ext_vector_type(8)));
typedef float f32x4 __attribute__((ext_vector_type(4)));
typedef unsigned u32x4 __attribute__((ext_vector_type(4)));
constexpr int BM = 256, BK = 64, HALF = 128, HTB = HALF * BK * 2  , STAGE_BYTES = 8 * HTB, NXCD = 8, WGM = 8;

__host__ __device__ __forceinline__ int lds_byte(int r, int c) { const int st = (r >> 4) * 2 + (c >> 5), rr = r & 15, cc = c & 31, ob = rr * 64 + cc * 2; return st * 1024 + (ob ^ (((ob >> 9) & 1) << 5)); }
__host__ __device__ __forceinline__ void stage_rc(int b, int& R, int& C) { const int st = b / 1024, sb = b % 1024, swz = sb ^ (((sb >> 9) & 1) << 5); R = (st >> 1) * 16 + swz / 64; C = (st & 1) * 32 + (swz % 64) / 2; }
__host__ __device__ __forceinline__ int perm32(int rho) { const int n = rho >> 4, i = rho & 15; return 8 * (i >> 2) + 4 * n + (i & 3); }

struct Unit { int pm, pn; };
struct Gemm { const bf16_t* A; const bf16_t* Bt; int M, N, K; };

struct StaticOrder {
    int nM, nN, nwg, G, c;
    __host__ __device__ void init(int M, int N, int G_, int c_) { nM = M / BM; nN = N / BM; nwg = nM * nN; G = G_; c = c_; }
    __host__ __device__ bool next(int i, Unit& u) const {
        const long L = (long)i * G + c; if (L >= nwg) return false;
        int wgid = (int)L; { const int q = nwg / NXCD, r = nwg % NXCD, xcd = wgid % NXCD, off = wgid / NXCD; wgid = (xcd < r ? xcd * (q + 1) : r * (q + 1) + (xcd - r) * q) + off; }
        const int nig = WGM * nN, gid = wgid / nig, fm = gid * WGM, gsz = (nM - fm) < WGM ? (nM - fm) : WGM;
        u.pm = fm + ((wgid % nig) % gsz); u.pn = (wgid % nig) / gsz; return true;
    }
    __device__ __forceinline__ void a_ready(const Unit&) const {}
    __device__ __forceinline__ void done(const Unit&) const {}
};

__device__ __forceinline__ unsigned cvt_pk_bf16(float lo, float hi) { unsigned r; asm volatile("v_cvt_pk_bf16_f32 %0, %1, %2" : "=v"(r) : "v"(lo), "v"(hi)); return r; }
typedef float f32x2 __attribute__((ext_vector_type(2)));
struct EpiInProj {
    static constexpr bool PERM = true, AFTER_DRAIN = false;
    bf16_t* Z; const float* cosT; const float* sinT;
    __device__ __forceinline__ void operator()(const f32x4 (&acc)[2][2][4][2], const Unit& u, int wr, int wc, int fr, int fq) const {
        const int row0 = u.pm * BM + wr * 64 + fr, colt = u.pn * BM, region = colt >> 9;
        const bool rope = (region == 1 || region == 2) && (u.pm < 64);
        const float sc = (region == 1) ? 0.18033688011112042f : 1.0f;
        const int col0 = colt + wc * 32 + 8 * fq, i0 = (wc & 1) * 16 + 4 * fq;
        f32x4 inv4;
#pragma unroll
        for (int jj = 0; jj < 4; ++jj) inv4[jj] = __builtin_amdgcn_exp2f(-(float)((i0 & 15) + jj) * (13.287712379549449f / 16.0f));
#pragma unroll
        for (int ai = 0; ai < 2; ++ai)
#pragma unroll
            for (int m = 0; m < 4; ++m) {
                const int row = row0 + ai * HALF + m * 16;
                f32x4 cs = (f32x4){1.f, 1.f, 1.f, 1.f}, sn = (f32x4){0.f, 0.f, 0.f, 0.f};
                if (rope) { const int t = row & 4095; const float pos = (float)((i0 < 16) ? (t >> 6) : (t & 63));
#pragma unroll
                    for (int jj = 0; jj < 4; ++jj) { const float ang = pos * inv4[jj]; cs[jj] = __cosf(ang); sn[jj] = __sinf(ang); } }
                bf16_t* rowp = Z + (size_t)row * 2048 + col0;
#pragma unroll
                for (int bj = 0; bj < 2; ++bj) {
                    const f32x4 v0 = acc[ai][bj][m][0], v1 = acc[ai][bj][m][1];
                    f32x4 o0, o1;
                    o0[0] = v0[0] * cs[0] - v0[1] * sn[0]; o0[1] = v0[0] * sn[0] + v0[1] * cs[0];
                    o0[2] = v0[2] * cs[1] - v0[3] * sn[1]; o0[3] = v0[2] * sn[1] + v0[3] * cs[1];
                    o1[0] = v1[0] * cs[2] - v1[1] * sn[2]; o1[1] = v1[0] * sn[2] + v1[1] * cs[2];
                    o1[2] = v1[2] * cs[3] - v1[3] * sn[3]; o1[3] = v1[2] * sn[3] + v1[3] * cs[3];
                    o0 = o0 * sc; o1 = o1 * sc;
                    u32x4 w; w.x = cvt_pk_bf16(o0[0], o0[1]); w.y = cvt_pk_bf16(o0[2], o0[3]); w.z = cvt_pk_bf16(o1[0], o1[1]); w.w = cvt_pk_bf16(o1[2], o1[3]);
                    *(u32x4*)(rowp + bj * HALF) = w;
                }
            }
    }
};
struct EpiSqRelu {
    static constexpr bool PERM = true, AFTER_DRAIN = false;
    bf16_t* O; int ldc;
    __device__ __forceinline__ void operator()(const f32x4 (&acc)[2][2][4][2], const Unit& u, int wr, int wc, int fr, int fq) const {
        const int row0 = u.pm * BM + wr * 64 + fr, col0 = u.pn * BM + wc * 32 + 8 * fq;
#pragma unroll
        for (int ai = 0; ai < 2; ++ai)
#pragma unroll
            for (int m = 0; m < 4; ++m) { bf16_t* rowp = O + (size_t)(row0 + ai * HALF + m * 16) * ldc + col0;
#pragma unroll
                for (int bj = 0; bj < 2; ++bj) { f32x4 v0 = acc[ai][bj][m][0], v1 = acc[ai][bj][m][1];
#pragma unroll
                    for (int j = 0; j < 4; ++j) { const float a = fmaxf(v0[j], 0.f), b = fmaxf(v1[j], 0.f); v0[j] = a * a; v1[j] = b * b; }
                    u32x4 w; w.x = cvt_pk_bf16(v0[0], v0[1]); w.y = cvt_pk_bf16(v0[2], v0[3]); w.z = cvt_pk_bf16(v1[0], v1[1]); w.w = cvt_pk_bf16(v1[2], v1[3]);
                    *(u32x4*)(rowp + bj * HALF) = w; } }
    }
};
struct EpiRes {
    static constexpr bool PERM = true, AFTER_DRAIN = false;
    const float* res_lat32; const float* res_ctx32; const bf16_t* res16; bf16_t* out16; const float* gate;
    __device__ __forceinline__ void operator()(const f32x4 (&acc)[2][2][4][2], const Unit& u, int wr, int wc, int fr, int fq) const {
        const int row0 = u.pm * BM + wr * 64 + fr, col0 = u.pn * BM + wc * 32 + 8 * fq;
        const bool lat = u.pm < 64; const int b = lat ? (u.pm >> 4) : 4;
        const float* gp = gate + (size_t)b * 6144 + col0;
        f32x4 gv[2][2];
#pragma unroll
        for (int bj = 0; bj < 2; ++bj)
#pragma unroll
            for (int n = 0; n < 2; ++n) gv[bj][n] = *(const f32x4*)(gp + bj * HALF + 4 * n);
#pragma unroll
        for (int ai = 0; ai < 2; ++ai)
#pragma unroll
            for (int m = 0; m < 4; ++m) { const int row = row0 + ai * HALF + m * 16;
                bf16_t* op = out16 + (size_t)row * 1024 + col0;
#pragma unroll
                for (int bj = 0; bj < 2; ++bj) { f32x4 r0, r1;
                    if (res16) { const u32x4 q = *(const u32x4*)(res16 + (size_t)row * 1024 + col0 + bj * HALF);
                        r0 = (f32x4){__builtin_bit_cast(float, q.x << 16), __builtin_bit_cast(float, q.x & 0xffff0000u), __builtin_bit_cast(float, q.y << 16), __builtin_bit_cast(float, q.y & 0xffff0000u)};
                        r1 = (f32x4){__builtin_bit_cast(float, q.z << 16), __builtin_bit_cast(float, q.z & 0xffff0000u), __builtin_bit_cast(float, q.w << 16), __builtin_bit_cast(float, q.w & 0xffff0000u)}; }
                    else { const float* rp = (lat ? res_lat32 + (size_t)row * 1024 : res_ctx32 + (size_t)(row - 16384) * 1024) + col0 + bj * HALF;
                        r0 = *(const f32x4*)rp; r1 = *(const f32x4*)(rp + 4); }
                    const f32x4 o0 = r0 + gv[bj][0] * acc[ai][bj][m][0], o1 = r1 + gv[bj][1] * acc[ai][bj][m][1];
                    u32x4 w; w.x = cvt_pk_bf16(o0[0], o0[1]); w.y = cvt_pk_bf16(o0[2], o0[3]); w.z = cvt_pk_bf16(o1[0], o1[1]); w.w = cvt_pk_bf16(o1[2], o1[3]);
                    *(u32x4*)(op + bj * HALF) = w; } }
    }
};
template <class Epi, class Sched, bool ALIGN_EPI = false, bool SP2 = false>
__device__ __forceinline__ void gemm_phase(PG8_LAS unsigned char* lds, const Gemm g, const Sched& S, const Epi& E) {
    int tid = threadIdx.x; asm volatile("" : "+v"(tid));
    const int wid = __builtin_amdgcn_readfirstlane(tid >> 6), lane = tid & 63, wr = wid >> 2, wc = wid & 3, fr = lane & 15, fq = lane >> 4;
    const int K = g.K, nt = K / BK;
    unsigned voffA[2], voffB[2];
#pragma unroll
    for (int i = 0; i < 2; ++i) { int R, C; stage_rc(tid * 16 + i * 8192, R, C); const int Rb = Epi::PERM ? ((R & ~31) + perm32(R & 31)) : R;
        voffA[i] = (unsigned)(R * K + C) * 2u; voffB[i] = (unsigned)(Rb * K + C) * 2u; }
    const size_t kstep = (size_t)(BK * 2);
    const size_t hstep = (size_t)HALF * K * 2;
    const size_t tstep = 2 * hstep;
    const unsigned ldsw = (unsigned)wid * 1024u;
    const int aoff = lds_byte(wr * 64 + fr, fq * 8), boff = lds_byte(wc * 32 + fr, fq * 8);
#define PG8_SA(b, h) (((b) * 2 + (h)) * HTB)
#define PG8_SB(b, h) ((4 + (b) * 2 + (h)) * HTB)
#define PG8_STAGE(bufoff, gbase, voff) do { _Pragma("unroll") for (int _i = 0; _i < 2; ++_i) \
        __builtin_amdgcn_global_load_lds((const unsigned*)((const char*)(gbase) + (voff)[_i]), (PG8_LAS unsigned*)(lds + (bufoff) + ldsw + _i * 8192), 16, 0, 0); } while (0)
#define PG8_LDA(dst, b, h) do { _Pragma("unroll") for (int m = 0; m < 4; ++m) _Pragma("unroll") for (int k = 0; k < 2; ++k) dst[m][k] = *(const PG8_LAS bf16x8*)(lds + PG8_SA(b, h) + aoff + m * 2048 + k * 1024); } while (0)
#define PG8_LDB(dst, b, h) do { _Pragma("unroll") for (int n = 0; n < 2; ++n) _Pragma("unroll") for (int k = 0; k < 2; ++k) dst[n][k] = *(const PG8_LAS bf16x8*)(lds + PG8_SB(b, h) + boff + n * 2048 + k * 1024); } while (0)
#define PG8_MMA(ai, bj, At, Bt) do { __builtin_amdgcn_s_setprio(1); _Pragma("unroll") for (int m = 0; m < 4; ++m) _Pragma("unroll") for (int n = 0; n < 2; ++n) _Pragma("unroll") for (int k = 0; k < 2; ++k) \
        acc[ai][bj][m][n] = __builtin_amdgcn_mfma_f32_16x16x32_bf16(Bt[n][k], At[m][k], acc[ai][bj][m][n], 0, 0, 0); __builtin_amdgcn_s_setprio(0); } while (0)
#define PG8_WAIT_V(n) asm volatile("s_waitcnt vmcnt(" #n ")" ::: "memory")
#define PG8_WAIT_L(n) asm volatile("s_waitcnt lgkmcnt(" #n ")" ::: "memory")
#define PG8_BAR __builtin_amdgcn_s_barrier()
#define PG8_SCHED __builtin_amdgcn_sched_barrier(0)
    Unit cur, nxt; int ui = 0;
    if (!S.next(0, cur)) return;
    f32x4 acc[2][2][4][2];
#pragma unroll
    for (int a = 0; a < 2; ++a)
#pragma unroll
        for (int b = 0; b < 2; ++b)
#pragma unroll
            for (int m = 0; m < 4; ++m)
#pragma unroll
                for (int n = 0; n < 2; ++n) acc[a][b][m][n] = (f32x4){0.f, 0.f, 0.f, 0.f};
    bf16x8 At[4][2], B0[2][2], B1[2][2];
    const char* cA = (const char*)g.A + (size_t)cur.pm * tstep; const char* cB = (const char*)g.Bt + (size_t)cur.pn * tstep;
    S.a_ready(cur);
    if constexpr (SP2) {
        PG8_STAGE(PG8_SB(0, 0), cB, voffB); PG8_STAGE(PG8_SB(0, 1), cB + hstep, voffB); PG8_STAGE(PG8_SA(0, 0), cA, voffA); PG8_STAGE(PG8_SA(0, 1), cA + hstep, voffA);
        if (wr == 1) PG8_BAR;
        PG8_WAIT_V(2); PG8_BAR;
        PG8_STAGE(PG8_SB(1, 0), cB + kstep, voffB); PG8_STAGE(PG8_SA(1, 0), cA + kstep, voffA); PG8_STAGE(PG8_SB(1, 1), cB + hstep + kstep, voffB);
        PG8_WAIT_V(6); PG8_BAR;
    } else {
        PG8_STAGE(PG8_SB(0, 0), cB, voffB); PG8_STAGE(PG8_SA(0, 0), cA, voffA); PG8_STAGE(PG8_SB(0, 1), cB + hstep, voffB); PG8_STAGE(PG8_SA(0, 1), cA + hstep, voffA);
        if (wr == 1) PG8_BAR;
        PG8_WAIT_V(4); PG8_BAR;
        PG8_STAGE(PG8_SB(1, 0), cB + kstep, voffB); PG8_STAGE(PG8_SA(1, 0), cA + kstep, voffA); PG8_STAGE(PG8_SB(1, 1), cB + hstep + kstep, voffB);
        PG8_WAIT_V(6); PG8_BAR;
    }
    for (;;) {
        const bool has_next = S.next(ui + 1, nxt);
        const char* nA = has_next ? (const char*)g.A + (size_t)nxt.pm * tstep : cA; const char* nB = has_next ? (const char*)g.Bt + (size_t)nxt.pn * tstep : cB;
        for (int t = 0; t < nt; t += 2) {
            const bool last = (t == nt - 2);
            const char* a1 = cA + (size_t)(t + 1) * kstep;
            const char* a2 = last ? nA : cA + (size_t)(t + 2) * kstep; const char* b2 = last ? nB : cB + (size_t)(t + 2) * kstep;
            const char* a3 = a2 + kstep; const char* b3 = b2 + kstep;
            if (last && has_next) S.a_ready(nxt);
            if constexpr (SP2) {
            PG8_LDB(B0, 0, 0); PG8_LDB(B1, 0, 1); PG8_SCHED; PG8_LDA(At, 0, 0); PG8_STAGE(PG8_SA(1, 1), a1 + hstep, voffA);
            PG8_WAIT_V(8); PG8_WAIT_L(0); PG8_BAR; PG8_MMA(0, 0, At, B0); PG8_MMA(0, 1, At, B1); PG8_BAR; PG8_SCHED;
            PG8_LDA(At, 0, 1); PG8_STAGE(PG8_SB(0, 0), b2, voffB); PG8_STAGE(PG8_SB(0, 1), b2 + hstep, voffB); PG8_STAGE(PG8_SA(0, 0), a2, voffA);
            PG8_WAIT_V(8); PG8_WAIT_L(0); PG8_BAR; PG8_MMA(1, 0, At, B0); PG8_MMA(1, 1, At, B1); PG8_BAR; PG8_SCHED;
            PG8_LDB(B0, 1, 0); PG8_LDB(B1, 1, 1); PG8_SCHED; PG8_LDA(At, 1, 0); PG8_STAGE(PG8_SA(0, 1), a2 + hstep, voffA);
            PG8_WAIT_V(8); PG8_WAIT_L(0); PG8_BAR; PG8_MMA(0, 0, At, B0); PG8_MMA(0, 1, At, B1); PG8_BAR; PG8_SCHED;
            PG8_LDA(At, 1, 1); PG8_STAGE(PG8_SB(1, 0), b3, voffB); PG8_STAGE(PG8_SB(1, 1), b3 + hstep, voffB); PG8_STAGE(PG8_SA(1, 0), a3, voffA);
            PG8_WAIT_V(8); PG8_WAIT_L(0); PG8_BAR; PG8_MMA(1, 0, At, B0); PG8_MMA(1, 1, At, B1); PG8_BAR; PG8_SCHED;
            } else {
            PG8_LDB(B0, 0, 0); PG8_SCHED; PG8_LDA(At, 0, 0); PG8_STAGE(PG8_SA(1, 1), a1 + hstep, voffA);
            PG8_WAIT_L(8); PG8_BAR; PG8_WAIT_L(0); PG8_MMA(0, 0, At, B0); PG8_BAR; PG8_SCHED;
            PG8_LDB(B1, 0, 1); PG8_STAGE(PG8_SB(0, 0), b2, voffB);
            PG8_BAR; PG8_WAIT_L(0); PG8_MMA(0, 1, At, B1); PG8_BAR;
            PG8_LDA(At, 0, 1); PG8_STAGE(PG8_SA(0, 0), a2, voffA);
            PG8_BAR; PG8_WAIT_L(0); PG8_MMA(1, 0, At, B0); PG8_BAR; PG8_SCHED;
            PG8_STAGE(PG8_SB(0, 1), b2 + hstep, voffB);
            PG8_WAIT_V(6); PG8_BAR; PG8_MMA(1, 1, At, B1); PG8_BAR;
            PG8_LDB(B0, 1, 0); PG8_SCHED; PG8_LDA(At, 1, 0); PG8_STAGE(PG8_SA(0, 1), a2 + hstep, voffA);
            PG8_WAIT_L(8); PG8_BAR; PG8_WAIT_L(0); PG8_MMA(0, 0, At, B0); PG8_BAR; PG8_SCHED;
            PG8_LDB(B1, 1, 1); PG8_STAGE(PG8_SB(1, 0), b3, voffB);
            PG8_BAR; PG8_WAIT_L(0); PG8_MMA(0, 1, At, B1); PG8_BAR;
            PG8_LDA(At, 1, 1); PG8_STAGE(PG8_SA(1, 0), a3, voffA);
            PG8_BAR; PG8_WAIT_L(0); PG8_MMA(1, 0, At, B0); PG8_BAR; PG8_SCHED;
            PG8_STAGE(PG8_SB(1, 1), b3 + hstep, voffB);
            PG8_WAIT_V(6); PG8_BAR; PG8_MMA(1, 1, At, B1); PG8_BAR;
            }
        }
        if constexpr (ALIGN_EPI) { if (wr == 0) PG8_BAR; }
        if constexpr (!Epi::AFTER_DRAIN) { E(acc, cur, wr, wc, fr, fq); S.done(cur); }
        if (!has_next) break;
#pragma unroll
        for (int a = 0; a < 2; ++a)
#pragma unroll
            for (int b = 0; b < 2; ++b)
#pragma unroll
                for (int m = 0; m < 4; ++m)
#pragma unroll
                    for (int n = 0; n < 2; ++n) acc[a][b][m][n] = (f32x4){0.f, 0.f, 0.f, 0.f};
        cur = nxt; cA = nA; cB = nB; ++ui;
        if constexpr (ALIGN_EPI) { if (wr == 1) PG8_BAR; }
    }
    PG8_WAIT_V(0);
    if constexpr (!ALIGN_EPI) { if (wr == 0) PG8_BAR; }
    PG8_BAR;
    if constexpr (Epi::AFTER_DRAIN) { E.fused(acc, cur, wr, wc, fr, fq, lds, wid, lane); S.done(cur); }
#undef PG8_SA
#undef PG8_SB
#undef PG8_STAGE
#undef PG8_LDA
#undef PG8_LDB
#undef PG8_MMA
#undef PG8_WAIT_V
#undef PG8_WAIT_L
#undef PG8_BAR
#undef PG8_SCHED
}
}

#define LAS __attribute__((address_space(3)))
typedef unsigned short bf16;
typedef unsigned v4u __attribute__((ext_vector_type(4)));
typedef unsigned v2u __attribute__((ext_vector_type(2)));
typedef float f32x4 __attribute__((ext_vector_type(4)));
typedef float f32x2 __attribute__((ext_vector_type(2)));
typedef float f32x16 __attribute__((ext_vector_type(16)));
typedef short bf16x8 __attribute__((ext_vector_type(8)));
typedef short s16x4 __attribute__((ext_vector_type(4)));

constexpr int DM = 1024, SEQ = 4096, CTXL = 256, NBATCH = 4, MLAT = 16384, MTOT = 17408, INW = 2048, DFF = 4096, NLAYER = 4, NADA = 6144;
constexpr size_t MiB = 1u << 20;
constexpr size_t WS_BAR = 512 * 1024, WS_BAR_BYTES = 16384;
constexpr size_t WS_ADA = 0, WS_ROPE = 1 * MiB, WS_W = 2 * MiB, W_LAYER = 23 * MiB;
constexpr size_t WO_IN = 0, WO_OUT = 4 * MiB, WO_1 = 6 * MiB, WO_2 = 14 * MiB, WO_P = 22 * MiB;
constexpr size_t WS_X = 94 * MiB, WS_H = 162 * MiB, WS_Z = 196 * MiB, WS_MIX = 264 * MiB, WS_A = 196 * MiB, WS_PART = 332 * MiB, WS_END = 348 * MiB;
constexpr int LDS_BYTES = 147456, LDS_CTL = 143360;
constexpr int NWAVES = 8;

struct Params {
    const float *x, *c, *ctx, *c_ctx, *w_ada, *b_ada, *g_mix, *g_mlp, *w_in, *w_pool, *s_pool, *lq1, *lk1, *lq2, *lk2, *g_sub, *w_out, *w1, *w2, *g_final;
    float* out; unsigned char* ws;
};

__device__ __forceinline__ unsigned f2bf(float f) { unsigned u = __builtin_bit_cast(unsigned, f); return (u + 0x7fffu + ((u >> 16) & 1u)) >> 16; }
__device__ __forceinline__ unsigned pk2(float lo, float hi) { return f2bf(lo) | (f2bf(hi) << 16); }
__device__ __forceinline__ float bf2f(unsigned short v) { return __builtin_bit_cast(float, (unsigned)v << 16); }
__device__ __forceinline__ float shfl_xor_l(float v, int mask, int lane) { return __builtin_bit_cast(float, __builtin_amdgcn_ds_bpermute((lane ^ mask) << 2, __builtin_bit_cast(int, v))); }
__device__ __forceinline__ float wave_sum(float v, int lane) {
#define WS_ROR(n_) __builtin_bit_cast(float, __builtin_amdgcn_update_dpp(0, __builtin_bit_cast(int, v), 0x120 + (n_), 0xf, 0xf, false))
    v += WS_ROR(8); v += WS_ROR(4); v += WS_ROR(2); v += WS_ROR(1);
#undef WS_ROR
    v += shfl_xor_l(v, 16, lane); v += shfl_xor_l(v, 32, lane);
    return v;
}

__device__ __forceinline__ int inproj_dest(int n) { if (n < 512 || n >= 1536) return n; const int p = n & 63, nb = n - p; return nb + 2 * (p & 31) + (p >> 5); }
template <bool PERMQK>
__device__ __forceinline__ void transpose_item(const float* W, int K, int N, bf16* WT, LAS float* scr, int item, int lane) {
    const int nblk = N / 32, kb = item / nblk, nb = item % nblk, k0 = 64 * kb, n0 = 32 * nb;
    { const int kr = lane >> 3, c4 = lane & 7;
      f32x4 tv[8];
#pragma unroll
      for (int i = 0; i < 8; ++i) tv[i] = *(const f32x4*)(W + (size_t)(k0 + 8 * i + kr) * N + n0 + 4 * c4);
#pragma unroll
      for (int i = 0; i < 8; ++i) { LAS float* d = scr + (8 * i + kr) * 33 + 4 * c4; d[0] = tv[i].x; d[1] = tv[i].y; d[2] = tv[i].z; d[3] = tv[i].w; } }
    asm volatile("s_waitcnt lgkmcnt(0)" ::: "memory");
    const int c = lane & 7;
#pragma unroll
    for (int j = 0; j < 4; ++j) { const int n = (lane >> 3) + 8 * j; const LAS float* s = scr + (8 * c) * 33 + n;
        v4u o; o.x = pk2(s[0 * 33], s[1 * 33]); o.y = pk2(s[2 * 33], s[3 * 33]); o.z = pk2(s[4 * 33], s[5 * 33]); o.w = pk2(s[6 * 33], s[7 * 33]);
        const int nd = PERMQK ? inproj_dest(n0 + n) : (n0 + n);
        *(v4u*)(WT + (size_t)nd * K + k0 + 8 * c) = o; }
    asm volatile("s_waitcnt lgkmcnt(0)" ::: "memory");
}

__device__ __forceinline__ void prologue(const Params& p, LAS unsigned char* lds, int tid, int lane, int wid) {
    const int G = gridDim.x, bx = blockIdx.x;
    float* ada = (float*)(p.ws + WS_ADA);
    if (bx < 192) {
        LAS float* S = (LAS float*)lds;
        LAS float* P = (LAS float*)(lds + 20480);
        for (int idx = tid; idx < 5 * 1024; idx += 512) { const int r = idx >> 10, k = idx & 1023; const float v = (r < 4) ? p.c[r * 1024 + k] : p.c_ctx[k]; S[idx] = v / (1.f + __expf(-v)); }
        __syncthreads();
        for (int it = bx; it < 192; it += G) {
            const int l = it / 48, j0 = (it % 48) * 128;
            const float* wp = p.w_ada + ((size_t)l * 1024 + wid * 128) * NADA + j0 + 2 * lane;
            f32x2 a0 = {0.f, 0.f}, a1 = a0, a2 = a0, a3 = a0, a4 = a0;
#pragma unroll 16
            for (int k = 0; k < 128; ++k) { const f32x2 w = *(const f32x2*)(wp + (size_t)k * NADA); const int kk = wid * 128 + k;
                a0 += w * S[kk]; a1 += w * S[1024 + kk]; a2 += w * S[2048 + kk]; a3 += w * S[3072 + kk]; a4 += w * S[4096 + kk]; }
            LAS float* pw = P + wid * 640 + 2 * lane;
            *(LAS f32x2*)(pw) = a0; *(LAS f32x2*)(pw + 128) = a1; *(LAS f32x2*)(pw + 256) = a2; *(LAS f32x2*)(pw + 384) = a3; *(LAS f32x2*)(pw + 512) = a4;
            __syncthreads();
            for (int o = tid; o < 640; o += 512) { const int r = o >> 7, j = o & 127; float s = p.b_ada[l * NADA + j0 + j];
#pragma unroll
                for (int w = 0; w < 8; ++w) s += P[w * 640 + o];
                ada[((size_t)l * 5 + r) * NADA + j0 + j] = s; }
            __syncthreads();
        }
    }
    __syncthreads();
    {
        float* cosT = (float*)(p.ws + WS_ROPE); float* sinT = cosT + 4096 * 32;
        for (int idx = bx * 512 + tid; idx < 4096 * 32; idx += G * 512) { const int t = idx >> 5, i = idx & 31;
            const float inv = exp2f(-(float)(i & 15) * (13.287712379549449f / 16.0f));
            const float ang = (float)((i < 16) ? (t >> 6) : (t & 63)) * inv;
            cosT[idx] = __cosf(ang); sinT[idx] = __sinf(ang); }
    }
    {
        LAS float* scr = (LAS float*)(lds + wid * 16384);
        const int gw = bx * NWAVES + wid, NGW = G * NWAVES;
        constexpr int I_IN = 16 * 64, I_OUT = 16 * 32, I_1 = 16 * 128, I_2 = 64 * 32, I_P = 4 * 8, I_L = I_IN + I_OUT + I_1 + I_2 + I_P;
        for (int it = gw; it < NLAYER * I_L; it += NGW) {
            const int l = it / I_L; int r = it % I_L;
            unsigned char* wl = p.ws + WS_W + (size_t)l * W_LAYER;
            if (r < I_IN) { transpose_item<true>(p.w_in + (size_t)l * DM * INW, DM, INW, (bf16*)(wl + WO_IN), scr, r, lane); continue; } r -= I_IN;
            if (r < I_OUT) { transpose_item<false>(p.w_out + (size_t)l * DM * DM, DM, DM, (bf16*)(wl + WO_OUT), scr, r, lane); continue; } r -= I_OUT;
            if (r < I_1) { transpose_item<false>(p.w1 + (size_t)l * DM * DFF, DM, DFF, (bf16*)(wl + WO_1), scr, r, lane); continue; } r -= I_1;
            if (r < I_2) { transpose_item<false>(p.w2 + (size_t)l * DFF * DM, DFF, DM, (bf16*)(wl + WO_2), scr, r, lane); continue; } r -= I_2;
            { const int g = r >> 3; transpose_item<false>(p.w_pool + ((size_t)l * 4 + g) * 128 * 128, 128, 128, (bf16*)(wl + WO_P) + g * 16384, scr, r & 7, lane); }
        }
    }
}

#define NORM_ROWS_BEGIN() const int gw = blockIdx.x * NWAVES + wid, NGW = gridDim.x * NWAVES; \
    int q_ = 0; while ((q_ + 1) * NGW <= nrows) ++q_;                         \
    const int rem_ = nrows - q_ * NGW, r0 = gw * q_ + (gw < rem_ ? gw : rem_), r1 = r0 + q_ + (gw < rem_ ? 1 : 0)
#define NORM_LOAD_MOD(b_) do { const f32x4* gp_ = (const f32x4*)g + lane; const f32x4* sh_ = (const f32x4*)(adal + (size_t)(b_) * NADA + shift_idx * DM) + lane; \
        const f32x4* sc_ = (const f32x4*)(adal + (size_t)(b_) * NADA + (shift_idx + 1) * DM) + lane; \
        _Pragma("unroll") for (int j = 0; j < 4; ++j) { Gm[j] = gp_[64 * j] * (sc_[64 * j] + 1.0f); Sh[j] = sh_[64 * j]; } } while (0)
__device__ __forceinline__ void norm_mod_phase(const float* src_lat, const float* src_ctx, const float* g, const float* adal, int shift_idx, bf16* H, int nrows, int lane, int wid) {
    NORM_ROWS_BEGIN();
    int bcur = -1; f32x4 Gm[4], Sh[4];
    for (int row = r0; row < r1; ++row) {
        const bool lat = row < MLAT; const int b = lat ? (row >> 12) : 4;
        if (b != bcur) { NORM_LOAD_MOD(b); bcur = b; }
        const f32x4* xr = (const f32x4*)(lat ? src_lat + (size_t)row * DM : src_ctx + (size_t)(row - MLAT) * DM) + lane;
        f32x4 v[4]; float s = 0.f;
#pragma unroll
        for (int j = 0; j < 4; ++j) { v[j] = xr[64 * j]; s += (v[j].x * v[j].x + v[j].y * v[j].y) + (v[j].z * v[j].z + v[j].w * v[j].w); }
        const float rinv = 1.0f / sqrtf(wave_sum(s, lane) * (1.f / DM) + 1e-6f);
        unsigned long long* o8 = (unsigned long long*)(H + (size_t)row * DM) + lane;
#pragma unroll
        for (int j = 0; j < 4; ++j) { const f32x4 y = v[j] * rinv * Gm[j] + Sh[j];
            o8[64 * j] = (unsigned long long)pk2(y.x, y.y) | ((unsigned long long)pk2(y.z, y.w) << 32); }
    }
}
__device__ __forceinline__ f32x4 unpack4(v2u q) { return (f32x4){__builtin_bit_cast(float, q.x << 16), __builtin_bit_cast(float, q.x & 0xffff0000u), __builtin_bit_cast(float, q.y << 16), __builtin_bit_cast(float, q.y & 0xffff0000u)}; }
__device__ __forceinline__ void norm_mod_phase16(bf16* X16, const float* g, const float* adal, int shift_idx, bf16* H, int nrows, int lane, int wid, const float* part = nullptr, const float* pgate = nullptr) {
    NORM_ROWS_BEGIN();
    int bcur = -1; f32x4 Gm[4], Sh[4];
    for (int row = r0; row < r1; ++row) {
        const int b = row < MLAT ? (row >> 12) : 4;
        if (b != bcur) { NORM_LOAD_MOD(b); bcur = b; }
        const v2u* xr = (const v2u*)(X16 + (size_t)row * DM) + lane;
        f32x4 v[4]; float s = 0.f;
#pragma unroll
        for (int j = 0; j < 4; ++j) v[j] = unpack4(xr[64 * j]);
        if (part != nullptr && row >= MLAT) {
            const f32x4* pp = (const f32x4*)(part + (size_t)(row - MLAT) * DM) + lane; const f32x4* pg = (const f32x4*)pgate + lane;
#pragma unroll
            for (int j = 0; j < 4; ++j) { const f32x4 t = (pp[64 * j] + pp[64 * j + 262144]) + (pp[64 * j + 2 * 262144] + pp[64 * j + 3 * 262144]);
                v[j] += pg[64 * j] * t;
                v2u w; w.x = pk2(v[j].x, v[j].y); w.y = pk2(v[j].z, v[j].w); ((v2u*)(X16 + (size_t)row * DM) + lane)[64 * j] = w;
                v[j] = unpack4(w); }
        }
#pragma unroll
        for (int j = 0; j < 4; ++j) s += (v[j].x * v[j].x + v[j].y * v[j].y) + (v[j].z * v[j].z + v[j].w * v[j].w);
        const float rinv = 1.0f / sqrtf(wave_sum(s, lane) * (1.f / DM) + 1e-6f);
        unsigned long long* o8 = (unsigned long long*)(H + (size_t)row * DM) + lane;
#pragma unroll
        for (int j = 0; j < 4; ++j) { const f32x4 y = v[j] * rinv * Gm[j] + Sh[j];
            o8[64 * j] = (unsigned long long)pk2(y.x, y.y) | ((unsigned long long)pk2(y.z, y.w) << 32); }
    }
}
__device__ __forceinline__ void final_norm_phase(const bf16* X16, const float* g, float* out, int lane, int wid) {
    const int nrows = MLAT;
    NORM_ROWS_BEGIN();
    f32x4 Gm[4];
    { const f32x4* gp = (const f32x4*)g + lane;
#pragma unroll
      for (int j = 0; j < 4; ++j) Gm[j] = gp[64 * j]; }
    for (int row = r0; row < r1; ++row) {
        const v2u* xr = (const v2u*)(X16 + (size_t)row * DM) + lane;
        f32x4 v[4]; float s = 0.f;
#pragma unroll
        for (int j = 0; j < 4; ++j) { v[j] = unpack4(xr[64 * j]); s += (v[j].x * v[j].x + v[j].y * v[j].y) + (v[j].z * v[j].z + v[j].w * v[j].w); }
        const float rinv = 1.0f / sqrtf(wave_sum(s, lane) * (1.f / DM) + 1e-6f);
        f32x4* o = (f32x4*)(out + (size_t)row * DM) + lane;
#pragma unroll
        for (int j = 0; j < 4; ++j) o[64 * j] = v[j] * rinv * Gm[j];
    }
}
#undef NORM_ROWS_BEGIN
#undef NORM_LOAD_MOD

constexpr int POOL_PITCH = 1040;
__device__ __forceinline__ void pool_unit(LAS unsigned char* lds, const bf16* Z, bf16* MIX, const bf16* WpT, const float* spool, int tt, int tid, int lane, int wid) {
    const int row0 = tt * 64;
    int seq0, n; if (row0 < MLAT) { seq0 = row0 & ~4095; n = SEQ; } else { seq0 = MLAT + ((row0 - MLAT) & ~255); n = CTXL; }
    const int t0 = row0 - seq0;
    v4u uv[10];
#pragma unroll
    for (int i = 0; i < 10; ++i) { const int r = wid + 8 * i, tok = t0 - 8 + r; uv[i] = (v4u){0u, 0u, 0u, 0u};
        if (r < 79 && tok >= 0 && tok < n) uv[i] = *(const v4u*)(Z + (size_t)(seq0 + tok) * INW + lane * 8); }
    const int g = wid >> 1, dbase = (wid & 1) * 64, fr = lane & 15, fq = lane >> 4;
    bf16x8 af[4][4];
    { const bf16* Wg = WpT + g * 16384;
#pragma unroll
      for (int kk = 0; kk < 4; ++kk)
#pragma unroll
          for (int mi = 0; mi < 4; ++mi) af[kk][mi] = *(const bf16x8*)(Wg + (dbase + 16 * mi + fr) * 128 + 32 * kk + 8 * fq); }
#pragma unroll
    for (int i = 0; i < 10; ++i) { const int r = wid + 8 * i; if (r < 79) *(LAS v4u*)(lds + r * POOL_PITCH + lane * 16) = uv[i]; }
    __syncthreads();
    {
        const int cp = tid & 255, th = tid >> 8, gg = cp >> 6, w = 2 << gg, lo = w >> 1, hiw = (w >> 1) - 1;
        LAS unsigned* colw = (LAS unsigned*)lds + cp;
        constexpr int RW = POOL_PITCH / 4;
        const int ts = 32 * th;
        float s0 = 0.f, s1 = 0.f;
        for (int r = ts + 8 - lo; r <= ts + 8 + hiw; ++r) { const unsigned q = colw[r * RW]; s0 += __builtin_bit_cast(float, q << 16); s1 += __builtin_bit_cast(float, q & 0xffff0000u); }
        for (int i = 0; i < 32; ++i) { const int t = ts + i;
            const int tok = t0 + t; const int a = max(tok - lo, 0), e = min(tok + hiw, n - 1);
            const float rc = 1.0f / (float)(e - a + 1);
            const unsigned qo = colw[(t + 8 - lo) * RW], qi = colw[(t + 8) * RW];
            const float y0 = s0 * rc - __builtin_bit_cast(float, qi << 16), y1 = s1 * rc - __builtin_bit_cast(float, qi & 0xffff0000u);
            colw[(th ? 47 + t : t) * RW] = pk2(y0, y1);
            if (i < 31) { const unsigned qn = colw[(t + 9 + hiw) * RW];
                s0 += __builtin_bit_cast(float, qn << 16) - __builtin_bit_cast(float, qo << 16); s1 += __builtin_bit_cast(float, qn & 0xffff0000u) - __builtin_bit_cast(float, qo & 0xffff0000u); }
        }
    }
    __syncthreads();
    {
        f32x4 acc[4][4];
#pragma unroll
        for (int a = 0; a < 4; ++a)
#pragma unroll
            for (int b = 0; b < 4; ++b) acc[a][b] = (f32x4){0.f, 0.f, 0.f, 0.f};
#pragma unroll
        for (int kk = 0; kk < 4; ++kk) {
            bf16x8 bfr[4];
#pragma unroll
            for (int ni = 0; ni < 4; ++ni) { const int rowi = (ni < 2) ? 16 * ni + fr : 47 + 16 * ni + fr;
                bfr[ni] = *(const LAS bf16x8*)(lds + rowi * POOL_PITCH + (128 * g + 32 * kk + 8 * fq) * 2); }
#pragma unroll
            for (int mi = 0; mi < 4; ++mi)
#pragma unroll
                for (int ni = 0; ni < 4; ++ni) acc[mi][ni] = __builtin_amdgcn_mfma_f32_16x16x32_bf16(af[kk][mi], bfr[ni], acc[mi][ni], 0, 0, 0);
        }
#pragma unroll
        for (int mi = 0; mi < 4; ++mi) { const int d0 = dbase + 16 * mi + 4 * fq; const f32x4 sp = *(const f32x4*)(spool + 128 * g + d0);
#pragma unroll
            for (int ni = 0; ni < 4; ++ni) { const int t = 16 * ni + fr; const f32x4 v = acc[mi][ni] * sp;
                v2u w; w.x = pk2(v.x, v.y); w.y = pk2(v.z, v.w);
                *(v2u*)(MIX + (size_t)(row0 + t) * DM + 128 * g + d0) = w; } }
    }
    __syncthreads();
}

namespace att {
constexpr int BUF = 32768, K1_OFF = 0, K2_OFF = 8192, V_OFF = 16384, SCR_OFF = 4 * 32768;
__device__ __forceinline__ void glds16(const void* gsrc, unsigned lds_dst) { unsigned keep;
    asm volatile("s_mov_b32 %0, m0\n\ts_mov_b32 m0, %2\n\ts_nop 0\n\tglobal_load_lds_dwordx4 %1, off\n\ts_mov_b32 m0, %0" : "=&s"(keep) : "v"(gsrc), "s"(lds_dst) : "memory"); }
typedef short v4i16_t __attribute__((ext_vector_type(4)));
__device__ __forceinline__ int crow(int r, int hi) { return (r & 3) + 8 * (r >> 2) + 4 * hi; }
__device__ __forceinline__ bf16x8 pack8(const f32x16& x, int s) {
    typedef __bf16 bf16x2_t __attribute__((ext_vector_type(2)));
    v4u p;
#pragma unroll
    for (int j = 0; j < 4; ++j) { f32x2 v = {x[8 * s + 2 * j], x[8 * s + 2 * j + 1]}; bf16x2_t b = __builtin_convertvector(v, bf16x2_t); p[j] = __builtin_bit_cast(unsigned, b); }
    return __builtin_bit_cast(bf16x8, p);
}
__device__ __forceinline__ int tile_row(bool latent, int b, int t) { return latent ? (t < 4 ? MLAT + b * CTXL + 64 * t : b * SEQ + 64 * (t - 4)) : (MLAT + b * CTXL + 64 * t); }

__device__ __forceinline__ void attn_unit(LAS unsigned char* lds, const bf16* Z, bf16* MIX, int b, int h, int qrow0, int NT, bool latent, float lam, float oscale, const float* gsub, int tid, int lane, int wid) {
    const int r32 = lane & 31, hi = lane >> 5, qg = wid >> 1, s = wid & 1;
    const unsigned lds0 = (unsigned)(uintptr_t)lds;
    const int kkey = 8 * wid + (lane >> 3), kcs = (lane & 7) ^ ((kkey >> 1) & 7);
    const int ksrc = kkey * INW + 1024 + (2 * h) * 64 + kcs * 8;
    const int pc0 = wid, pc1 = wid + 8;
    const int vsrc0 = (16 * (pc0 & 3) + (lane >> 2)) * INW + 1536 + h * 128 + (pc0 >> 2) * 32 + (lane & 3) * 8;
    const int vsrc1 = (16 * (pc1 & 3) + (lane >> 2)) * INW + 1536 + h * 128 + (pc1 >> 2) * 32 + (lane & 3) * 8;
#define ATT_DMA(t, bo_) do { const bf16* base_ = Z + (size_t)tile_row(latent, b, (t)) * INW; const unsigned d_ = lds0 + (unsigned)(bo_); \
        glds16(base_ + ksrc, (unsigned)__builtin_amdgcn_readfirstlane(d_ + K1_OFF + wid * 1024)); glds16(base_ + ksrc + 64, (unsigned)__builtin_amdgcn_readfirstlane(d_ + K2_OFF + wid * 1024)); \
        glds16(base_ + vsrc0, (unsigned)__builtin_amdgcn_readfirstlane(d_ + V_OFF + pc0 * 1024)); glds16(base_ + vsrc1, (unsigned)__builtin_amdgcn_readfirstlane(d_ + V_OFF + pc1 * 1024)); } while (0)
#define ATT_WAIT_BAR(N) asm volatile("s_waitcnt vmcnt(" #N ") lgkmcnt(0)\n\ts_barrier" ::: "memory")
    ATT_DMA(0, 0); ATT_DMA(1, BUF); ATT_DMA(2, 2 * BUF);
    bf16x8 qr[4];
    { const bf16* Qp = Z + (size_t)(qrow0 + qg * 32 + r32) * INW + 512 + (2 * h + s) * 64 + hi * 8;
#pragma unroll
      for (int d0 = 0; d0 < 4; ++d0) qr[d0] = *(const bf16x8*)(Qp + d0 * 16); }
    asm volatile("" : "+v"(qr[0]), "+v"(qr[1]), "+v"(qr[2]), "+v"(qr[3]));
    ATT_WAIT_BAR(0);
    float m = 0.f, l = 0.f;
    f32x16 o[4];
#pragma unroll
    for (int d0 = 0; d0 < 4; ++d0)
#pragma unroll
        for (int i = 0; i < 16; ++i) o[d0][i] = 0.f;
    LAS float* scr = (LAS float*)(lds + SCR_OFF) + wid * 64;
    const int kbase = s ? K2_OFF : K1_OFF;
    const int vlane = (4 * hi + ((lane & 15) >> 2)) * 64 + ((lane >> 4) & 1) * 32 + (lane & 3) * 8;
    const int klane = kbase + r32 * 128;
    const int ksw = (r32 >> 1) & 7;
#define ATT_TR(p_) __builtin_bit_cast(s16x4, __builtin_amdgcn_ds_read_tr16_b64_v4i16((LAS v4i16_t*)(p_)))
#define ATT_VF(a_, i_) ((bf16x8){a_[2 * (i_)][0], a_[2 * (i_)][1], a_[2 * (i_)][2], a_[2 * (i_)][3], a_[2 * (i_) + 1][0], a_[2 * (i_) + 1][1], a_[2 * (i_) + 1][2], a_[2 * (i_) + 1][3]})
#define ATT_KLOAD(bo_) do { _Pragma("unroll") for (int d0 = 0; d0 < 4; ++d0) { const LAS unsigned char* ka = lds + (bo_) + klane + (((2 * d0 + hi) ^ ksw) * 16); \
            kf[2 * d0] = *(const LAS bf16x8*)ka; kf[2 * d0 + 1] = *(const LAS bf16x8*)(ka + 4096); } } while (0)
#define ATT_VLOAD(dst_, ks_) do { _Pragma("unroll") for (int d0 = 0; d0 < 4; ++d0) { const LAS unsigned char* vp = lds + bo + V_OFF + d0 * 4096 + (ks_) * 1024 + vlane; \
            dst_[d0 * 2] = ATT_TR(vp); dst_[d0 * 2 + 1] = ATT_TR(vp + 512); } } while (0)
#define ATT_PV(src_, ks_) do { _Pragma("unroll") for (int d0 = 0; d0 < 4; ++d0) o[d0] = __builtin_amdgcn_mfma_f32_32x32x16_bf16(pa[ks_], ATT_VF(src_, d0), o[d0], 0, 0, 0); } while (0)
#define ATT_QK(P0_, P1_) do { _Pragma("unroll") for (int i = 0; i < 16; ++i) { P0_[i] = 0.f; P1_[i] = 0.f; } \
        _Pragma("unroll") for (int d0 = 0; d0 < 4; ++d0) { P0_ = __builtin_amdgcn_mfma_f32_32x32x16_bf16(kf[2 * d0], qr[d0], P0_, 0, 0, 0); P1_ = __builtin_amdgcn_mfma_f32_32x32x16_bf16(kf[2 * d0 + 1], qr[d0], P1_, 0, 0, 0); } } while (0)
    f32x16 p0, p1;
#define ATT_ROWMAX(P0_, P1_, OUT_) do { float rm_ = fmaxf(P0_[0], P1_[0]); _Pragma("unroll") for (int i = 1; i < 16; ++i) rm_ = fmaxf(rm_, fmaxf(P0_[i], P1_[i])); OUT_ = fmaxf(rm_, shfl_xor_l(rm_, 32, lane)); } while (0)
    { bf16x8 kf[8]; ATT_KLOAD(0); ATT_QK(p0, p1); }
    float rm; ATT_ROWMAX(p0, p1, rm);
    int bo = 0, bo1 = BUF, bo2 = 2 * BUF, bo3 = 3 * BUF;
    for (int t = 0; t < NT; ++t) {
        if (t + 3 < NT) ATT_DMA(t + 3, bo3);
        bf16x8 kf[8]; ATT_KLOAD(bo1);
        s16x4 va[8], vb[8];
        ATT_VLOAD(va, 0);
        __builtin_amdgcn_sched_barrier(0);
        const bool first = (t == 0);
        if (first || __any(rm > 8.0f)) {
            const float dl = first ? rm : fmaxf(rm, 0.f);
            const float al = __builtin_amdgcn_exp2f(-dl);
            m += dl; l *= al;
#pragma unroll
            for (int i = 0; i < 16; ++i) { p0[i] -= dl; p1[i] -= dl; }
            if (hi == 0) scr[r32] = al;
            __builtin_amdgcn_wave_barrier();
#pragma unroll
            for (int i = 0; i < 16; ++i) { const float a = scr[crow(i, hi)];
#pragma unroll
                for (int d0 = 0; d0 < 4; ++d0) o[d0][i] *= a; }
            __builtin_amdgcn_wave_barrier();
        }
        __builtin_amdgcn_sched_barrier(0);
        f32x16 n0, n1;
        ATT_QK(n0, n1);
        f32x2 sacc = {0.f, 0.f};
#pragma unroll
        for (int i = 0; i < 16; i += 2) { p0[i] = __builtin_amdgcn_exp2f(p0[i]); p0[i + 1] = __builtin_amdgcn_exp2f(p0[i + 1]); sacc += (f32x2){p0[i], p0[i + 1]}; }
        bf16x8 pa[4]; pa[0] = pack8(p0, 0); pa[1] = pack8(p0, 1);
        __builtin_amdgcn_sched_barrier(0);
        ATT_VLOAD(vb, 1);
        ATT_PV(va, 0);
#pragma unroll
        for (int i = 0; i < 16; i += 2) { p1[i] = __builtin_amdgcn_exp2f(p1[i]); p1[i + 1] = __builtin_amdgcn_exp2f(p1[i + 1]); sacc += (f32x2){p1[i], p1[i + 1]}; }
        pa[2] = pack8(p1, 0); pa[3] = pack8(p1, 1);
        l += sacc.x + sacc.y;
        __builtin_amdgcn_sched_barrier(0);
        ATT_VLOAD(va, 2);
        __builtin_amdgcn_sched_barrier(0);
        ATT_PV(vb, 1);
        __builtin_amdgcn_sched_barrier(0);
        ATT_VLOAD(vb, 3);
        __builtin_amdgcn_sched_barrier(0);
        ATT_PV(va, 2);
        { const f32x2 nm2 = {-m, -m};
          _Pragma("unroll") for (int i = 0; i < 16; i += 2) { f32x2 a = {n0[i], n0[i + 1]}, c2 = {n1[i], n1[i + 1]}; a += nm2; c2 += nm2; n0[i] = a.x; n0[i + 1] = a.y; n1[i] = c2.x; n1[i + 1] = c2.y; } }
        ATT_PV(vb, 3);
        ATT_ROWMAX(n0, n1, rm);
        if (t + 3 < NT) ATT_WAIT_BAR(4); else ATT_WAIT_BAR(0);
        p0 = n0; p1 = n1;
        { const int tmp_ = bo; bo = bo1; bo1 = bo2; bo2 = bo3; bo3 = tmp_; }
    }
#undef ATT_ROWMAX
#undef ATT_KLOAD
#undef ATT_VLOAD
#undef ATT_PV
#undef ATT_QK
#undef ATT_TR
#undef ATT_VF
#undef ATT_DMA
#undef ATT_WAIT_BAR
    l += shfl_xor_l(l, 32, lane);
    if (hi == 0) scr[32 + r32] = 1.0f / l;
    __builtin_amdgcn_wave_barrier();
#pragma unroll
    for (int i = 0; i < 16; ++i) { const float a = scr[32 + crow(i, hi)];
#pragma unroll
        for (int d0 = 0; d0 < 4; ++d0) o[d0][i] *= a; }
    LAS float* ex = (LAS float*)lds + qg * 4096 + lane;
    if (s == 1) {
#pragma unroll
        for (int d0 = 0; d0 < 4; ++d0)
#pragma unroll
            for (int i = 0; i < 16; ++i) ex[(d0 * 16 + i) * 64] = o[d0][i];
    }
    __syncthreads();
    if (s == 0) {
        float ssq[16];
#pragma unroll
        for (int i = 0; i < 16; ++i) { float q = 0.f;
#pragma unroll
            for (int d0 = 0; d0 < 4; ++d0) { const float v = o[d0][i] - lam * ex[(d0 * 16 + i) * 64]; o[d0][i] = v; q += v * v; }
            ssq[i] = q; }
#define ATT_DPP_ROR(v_, n_) __builtin_bit_cast(float, __builtin_amdgcn_update_dpp(0, __builtin_bit_cast(int, (v_)), 0x120 + (n_), 0xf, 0xf, false))
#pragma unroll
        for (int i = 0; i < 16; ++i) { float v = ssq[i];
            v += ATT_DPP_ROR(v, 8); v += ATT_DPP_ROR(v, 4); v += ATT_DPP_ROR(v, 2); v += ATT_DPP_ROR(v, 1);
            ssq[i] = v + shfl_xor_l(v, 16, lane); }
#undef ATT_DPP_ROR
        float gs[4];
#pragma unroll
        for (int d0 = 0; d0 < 4; ++d0) gs[d0] = gsub[32 * d0 + r32] * oscale;
#pragma unroll
        for (int i = 0; i < 16; ++i) { const float rn = 1.0f / sqrtf(ssq[i] * (1.0f / 128.0f) + 1e-6f);
            bf16* op = MIX + (size_t)(qrow0 + qg * 32 + crow(i, hi)) * DM + 512 + h * 128 + r32;
#pragma unroll
            for (int d0 = 0; d0 < 4; ++d0) op[32 * d0] = (bf16)f2bf(o[d0][i] * rn * gs[d0]); }
    }
    __syncthreads();
}
}

namespace sg {
struct EpiZ {
    bf16* Z;
    __device__ __forceinline__ void operator()(int r, int c, const f32x4& a, int) const { const float sc = (c >= 512 && c < 1024) ? 0.18033688011112042f : 1.0f;
        v2u w; w.x = pk2(a.x * sc, a.y * sc); w.y = pk2(a.z * sc, a.w * sc); *(v2u*)(Z + (size_t)r * INW + c) = w; }
};
struct EpiSq {
    bf16* O;
    __device__ __forceinline__ void operator()(int r, int c, const f32x4& a, int) const { const float x = fmaxf(a.x, 0.f), y = fmaxf(a.y, 0.f), z = fmaxf(a.z, 0.f), w_ = fmaxf(a.w, 0.f);
        v2u w; w.x = pk2(x * x, y * y); w.y = pk2(z * z, w_ * w_); *(v2u*)(O + (size_t)r * DFF + c) = w; }
};
struct EpiR {
    const float* res32; const bf16* res16; bf16* out16; const float* gate;
    __device__ __forceinline__ void operator()(int r, int c, const f32x4& a, int) const { const f32x4 g = *(const f32x4*)(gate + c); f32x4 x;
        if (res16) { const v2u q = *(const v2u*)(res16 + (size_t)r * DM + c);
            x = (f32x4){__builtin_bit_cast(float, q.x << 16), __builtin_bit_cast(float, q.x & 0xffff0000u), __builtin_bit_cast(float, q.y << 16), __builtin_bit_cast(float, q.y & 0xffff0000u)}; }
        else x = *(const f32x4*)(res32 + (size_t)r * DM + c);
        const f32x4 o = x + g * a;
        v2u w; w.x = pk2(o.x, o.y); w.y = pk2(o.z, o.w); *(v2u*)(out16 + (size_t)r * DM + c) = w; }
};
struct EpiPart {
    float* P;
    __device__ __forceinline__ void operator()(int r, int c, const f32x4& a, int ks) const { *(f32x4*)(P + ((size_t)ks * 1024 + r) * DM + c) = a; }
};
template <int BN, class Epi, int BM = 64>
__device__ __forceinline__ void small_gemm(LAS unsigned char* lds, const bf16* A, const bf16* Bt, int M, int N, int K, const Epi& E, int tid, int lane, int wid, int KS = 1) {
    constexpr int BK = 128, MT = BM / 32, NTN = BN / 64, NAL = BM / 32, NBL = BN / 32, ABYTES = BM * BK * 2, BBYTES = BN * BK * 2, STAGE = ABYTES + BBYTES;
    const int nN = N / BN, nitems = (M / BM) * nN * KS, Kc = K / KS, nk = Kc / BK;
    const int wm = wid >> 2, wn = wid & 3, fr = lane & 15, fq = lane >> 4;
    const int srow = tid >> 4, sch = tid & 15;
    for (int item = blockIdx.x; item < nitems; item += gridDim.x) {
        const int ks = item % KS, tile = item / KS, pm = tile / nN, pn = tile % nN;
        const bf16* Ag = A + (size_t)(pm * BM + srow) * K + ks * Kc + sch * 8; const bf16* Bg = Bt + (size_t)(pn * BN + srow) * K + ks * Kc + sch * 8;
        f32x4 acc[MT][NTN];
#pragma unroll
        for (int m = 0; m < MT; ++m)
#pragma unroll
            for (int n = 0; n < NTN; ++n) acc[m][n] = (f32x4){0.f, 0.f, 0.f, 0.f};
        v4u ra[NAL], rb[NBL], ra2[NAL], rb2[NBL];
#define SG_LOAD(A_, B_, kt_) do { _Pragma("unroll") for (int j = 0; j < NAL; ++j) A_[j] = *(const v4u*)(Ag + (size_t)(32 * j) * K + (kt_) * BK); \
                          _Pragma("unroll") for (int j = 0; j < NBL; ++j) B_[j] = *(const v4u*)(Bg + (size_t)(32 * j) * K + (kt_) * BK); } while (0)
#define SG_STORE(A_, B_, b_) do { _Pragma("unroll") for (int j = 0; j < NAL; ++j) { const int r_ = srow + 32 * j; *(LAS v4u*)(lds + (b_) * STAGE + r_ * 256 + ((sch ^ (r_ & 15)) * 16)) = A_[j]; } \
                          _Pragma("unroll") for (int j = 0; j < NBL; ++j) { const int r_ = srow + 32 * j; *(LAS v4u*)(lds + (b_) * STAGE + ABYTES + r_ * 256 + ((sch ^ (r_ & 15)) * 16)) = B_[j]; } } while (0)
#define SG_COMPUTE(b_) do { const LAS unsigned char* sa = lds + (b_) * STAGE; const LAS unsigned char* sb = sa + ABYTES; \
            _Pragma("unroll") for (int kk = 0; kk < 4; ++kk) { bf16x8 af[MT], bfr[NTN]; \
                _Pragma("unroll") for (int m = 0; m < MT; ++m) { const int r_ = (BM / 2) * wm + 16 * m + fr; af[m] = *(const LAS bf16x8*)(sa + r_ * 256 + (((kk * 4 + fq) ^ (r_ & 15)) * 16)); } \
                _Pragma("unroll") for (int n = 0; n < NTN; ++n) { const int r_ = (BN / 4) * wn + 16 * n + fr; bfr[n] = *(const LAS bf16x8*)(sb + r_ * 256 + (((kk * 4 + fq) ^ (r_ & 15)) * 16)); } \
                _Pragma("unroll") for (int m = 0; m < MT; ++m) _Pragma("unroll") for (int n = 0; n < NTN; ++n) acc[m][n] = __builtin_amdgcn_mfma_f32_16x16x32_bf16(bfr[n], af[m], acc[m][n], 0, 0, 0); } } while (0)
        SG_LOAD(ra, rb, 0); SG_LOAD(ra2, rb2, 1); SG_STORE(ra, rb, 0);
        __syncthreads();
        for (int kt = 0; kt < nk; kt += 2) {
            if (kt + 2 < nk) SG_LOAD(ra, rb, kt + 2);
            SG_COMPUTE(0);
            SG_STORE(ra2, rb2, 1);
            __syncthreads();
            if (kt + 3 < nk) SG_LOAD(ra2, rb2, kt + 3);
            SG_COMPUTE(1);
            if (kt + 2 < nk) SG_STORE(ra, rb, 0);
            __syncthreads();
        }
#undef SG_COMPUTE
#undef SG_LOAD
#undef SG_STORE
#pragma unroll
        for (int m = 0; m < MT; ++m)
#pragma unroll
            for (int n = 0; n < NTN; ++n) E(pm * BM + (BM / 2) * wm + 16 * m + fr, pn * BN + (BN / 4) * wn + 16 * n + 4 * fq, acc[m][n], ks);
    }
}
}

#define XB_TMO      128
#define XB_XCNT(j)  (256  + 64 * (j))
#define XB_XSUB(j)  (1280 + 64 * (j))
#define XB_XGEN(j)  (2304 + 64 * (j))
#define XB_TOP      3328
#define XB_TOPGEN   3392
#define XCD_BAR_WORDS 3456
#define XB_SPIN_CAP (1u << 18)

__device__ __forceinline__ unsigned xb_ld(unsigned* p)              { return __hip_atomic_load(p, __ATOMIC_RELAXED, __HIP_MEMORY_SCOPE_AGENT); }
__device__ __forceinline__ unsigned xb_add(unsigned* p, unsigned v) { return __hip_atomic_fetch_add(p, v, __ATOMIC_RELAXED, __HIP_MEMORY_SCOPE_AGENT); }
__device__ __forceinline__ unsigned xb_xcc_id() { return (unsigned)__builtin_amdgcn_s_getreg((3 << 11) | 20) & 0xFu; }
#define XB_SPIN(cond, bar) do { unsigned _sp = 0; while (cond) { __builtin_amdgcn_s_sleep(1); \
    if ((++_sp & 255u) == 0u) { if (xb_ld(&(bar)[XB_TMO])) break; if (_sp > XB_SPIN_CAP) { atomicAdd(&(bar)[XB_TMO], 1u); break; } } } } while (0)

struct XcdBarrier {
    unsigned* bar; unsigned x;
    volatile LAS unsigned* st;
};

__device__ __forceinline__ XcdBarrier xcd_barrier_post(unsigned* bar, volatile LAS unsigned* st) {
    XcdBarrier b; b.bar = bar; b.x = (unsigned)__builtin_amdgcn_readfirstlane((int)xb_xcc_id()); b.st = st;
    if (threadIdx.x == 0) (void)xb_add(&bar[XB_XCNT(b.x)], 1u);
    return b;
}
__device__ __forceinline__ void xcd_barrier_complete(unsigned* bar, unsigned x, unsigned& nloc, unsigned& nx) {
    const unsigned G = gridDim.x * gridDim.y * gridDim.z;
    unsigned sum, cnt, mine, sp = 0u;
    for (;;) {
        sum = 0u; cnt = 0u; mine = 0u;
#pragma unroll
        for (unsigned j = 0; j < 16; ++j) { const unsigned c = xb_ld(&bar[XB_XCNT(j)]); sum += c; cnt += (c > 0u) ? 1u : 0u; mine = (j == x) ? c : mine; }
        if (sum == G) break;
        __builtin_amdgcn_s_sleep(1);
        if ((++sp & 255u) == 0u) { if (xb_ld(&bar[XB_TMO])) break; if (sp > XB_SPIN_CAP) { atomicAdd(&bar[XB_TMO], 1u); break; } }
    }
    nloc = mine > 0u ? mine : 1u; nx = cnt > 0u ? cnt : 1u;
}

__device__ __forceinline__ void xcd_barrier(const XcdBarrier& b) {
    asm volatile("s_waitcnt vmcnt(0)" ::: "memory");
    __syncthreads();
    if (threadIdx.x == 0) {
        unsigned* bar = b.bar;
        unsigned bx_ = b.x; asm volatile("" : "+s"(bx_));
        __builtin_amdgcn_s_waitcnt(0);
        unsigned nloc = b.st[0], nx = b.st[1];
        if (nloc == 0u) { xcd_barrier_complete(bar, bx_, nloc, nx); b.st[0] = nloc; b.st[1] = nx; }
        const unsigned old = xb_add(&bar[XB_XSUB(bx_)], 1u);
        const unsigned gen = old / nloc;
        if (old + 1u == (gen + 1u) * nloc) {
            __builtin_amdgcn_fence(__ATOMIC_RELEASE, "agent");
            asm volatile("s_waitcnt vmcnt(0)" ::: "memory");
            const unsigned og = xb_add(&bar[XB_TOP], 1u);
            const unsigned tg = og / nx;
            if (og + 1u == (tg + 1u) * nx) xb_add(&bar[XB_TOPGEN], 1u);
            else XB_SPIN(xb_ld(&bar[XB_TOPGEN]) == tg, bar);
            __builtin_amdgcn_fence(__ATOMIC_ACQUIRE, "agent");
            xb_add(&bar[XB_XGEN(bx_)], 1u);
            asm volatile("s_waitcnt vmcnt(0)" ::: "memory");
        } else {
            XB_SPIN(xb_ld(&bar[XB_XGEN(bx_)]) == gen, bar);
            __builtin_amdgcn_fence(__ATOMIC_ACQUIRE, "agent");
            asm volatile("s_waitcnt vmcnt(0)" ::: "memory");
        }
    }
    __syncthreads();
}

__global__ void __launch_bounds__(512, 2) mega_fwd(Params p) {
    extern __shared__ __attribute__((aligned(16))) unsigned char lds_raw[];
    LAS unsigned char* lds = (LAS unsigned char*)lds_raw;
    cg::grid_group grid = cg::this_grid();
    int tid = threadIdx.x, lane = tid & 63, wid = __builtin_amdgcn_readfirstlane(tid >> 6);
#define OPAQUE_TID() do { tid = threadIdx.x; asm volatile("" : "+v"(tid)); lane = tid & 63; wid = __builtin_amdgcn_readfirstlane(tid >> 6); } while (0)
    const int G = gridDim.x, bx = blockIdx.x;
    const int vcu = (G % 8 == 0) ? (bx % 8) * (G / 8) + bx / 8 : bx;
    unsigned char* ws = p.ws;
    if (tid < 16) ((LAS unsigned*)(lds + LDS_CTL))[tid] = 0u;
    __syncthreads();
    const XcdBarrier xbar = xcd_barrier_post((unsigned*)(ws + WS_BAR), (volatile LAS unsigned*)(lds + LDS_CTL));
    float* ada = (float*)(ws + WS_ADA);
    const float* cosT = (const float*)(ws + WS_ROPE); const float* sinT = cosT + 4096 * 32;
    bf16* X16 = (bf16*)(ws + WS_X);
    bf16* H = (bf16*)(ws + WS_H); bf16* Z = (bf16*)(ws + WS_Z); bf16* MIX = (bf16*)(ws + WS_MIX); bf16* A = (bf16*)(ws + WS_A);

#ifndef NO_PRO
    for (int rep_ = 0; rep_ < REP_N; ++rep_) { prologue(p, lds, tid, lane, wid); __syncthreads(); }
#endif
    if (ws == nullptr) grid.sync();
    xcd_barrier(xbar);

    for (int l = 0; l < NLAYER; ++l) {
        const bool last = (l == NLAYER - 1);
        const int rows2 = last ? MLAT : MTOT;
        const unsigned char* wl = ws + WS_W + (size_t)l * W_LAYER;
        const float* adal = ada + (size_t)l * 5 * NADA;
        const bool l0 = (l == 0);

        OPAQUE_TID();
        if (l0) norm_mod_phase(p.x, p.ctx, p.g_mix + l * DM, adal, 0, H, MTOT, lane, wid);
        else norm_mod_phase16(X16, p.g_mix + l * DM, adal, 0, H, MTOT, lane, wid, (const float*)(ws + WS_PART), ada + ((size_t)(l - 1) * 5 + 4) * NADA + 5 * DM);
        GSYNC();
        { pg8::Gemm g{H, (const bf16*)(wl + WO_IN), MLAT, INW, DM}; pg8::StaticOrder S; S.init(MLAT, INW, G, bx);
          pg8::EpiInProj E{Z, cosT, sinT};
          for (int rep_ = 0; rep_ < REP_G; ++rep_) pg8::gemm_phase<pg8::EpiInProj, pg8::StaticOrder, true, true>(lds, g, S, E); }
        { OPAQUE_TID(); sg::EpiZ E{Z + (size_t)MLAT * INW};
          sg::small_gemm<128, sg::EpiZ>(lds, H + (size_t)MLAT * DM, (const bf16*)(wl + WO_IN), MTOT - MLAT, INW, DM, E, tid, lane, wid); }
        GSYNC();
        OPAQUE_TID();
        {
            float lam, lam_init = 0.8f - 0.6f * __expf(-0.3f * (float)l);
            { const float a = p.lq1[l * 64 + lane] * p.lk1[l * 64 + lane], c2 = p.lq2[l * 64 + lane] * p.lk2[l * 64 + lane];
              lam = __expf(wave_sum(a, lane)) - __expf(wave_sum(c2, lane)) + lam_init; }
            const float oscale = 1.0f - lam_init;
            const float* gsub = p.g_sub + l * 128;
            _Pragma("nounroll") for (int rep_ = 0; rep_ < REP_ATT; ++rep_) {
            const int natt = last ? 512 : 544;
            _Pragma("nounroll") for (int u = vcu; u < natt; u += G) {
                OPAQUE_TID();
                int b, h, qrow0, NT; bool latent;
                if (u < 512) { const int bh = u >> 5, qb = u & 31; b = bh >> 2; h = bh & 3; qrow0 = b * SEQ + qb * 128; NT = 68; latent = true; }
                else { const int v = u - 512, bh = v >> 1, qb = v & 1; b = bh >> 2; h = bh & 3; qrow0 = MLAT + b * CTXL + qb * 128; NT = 4; latent = false; }
                att::attn_unit(lds, Z, MIX, b, h, qrow0, NT, latent, lam, oscale, gsub, tid, lane, wid);
            }
            const int nctx = last ? 0 : 32, NE = nctx + (last ? 256 : 272);
            _Pragma("nounroll") for (int r = 0; r * G < NE; ++r) { const int e = r * G + ((r & 1) ? G - 1 - vcu : vcu);
                if (e >= nctx && e < NE) { OPAQUE_TID(); pool_unit(lds, Z, MIX, (const bf16*)(wl + WO_P), p.s_pool + l * 512, e - nctx, tid, lane, wid); } }
            }
        }
        GSYNC();
        { pg8::Gemm g{MIX, (const bf16*)(wl + WO_OUT), MLAT, DM, DM}; pg8::StaticOrder S; S.init(MLAT, DM, G, bx);
          pg8::EpiRes E{p.x, p.ctx, l0 ? (const bf16*)nullptr : (const bf16*)X16, X16, adal + 2 * DM};
          pg8::gemm_phase<pg8::EpiRes, pg8::StaticOrder, true, true>(lds, g, S, E); }
        if (!last) { OPAQUE_TID(); sg::EpiR E{p.ctx, l0 ? (const bf16*)nullptr : (const bf16*)(X16 + (size_t)MLAT * DM), X16 + (size_t)MLAT * DM, adal + 4 * NADA + 2 * DM};
          sg::small_gemm<64, sg::EpiR>(lds, MIX + (size_t)MLAT * DM, (const bf16*)(wl + WO_OUT), MTOT - MLAT, DM, DM, E, tid, lane, wid); }
        GSYNC();
        OPAQUE_TID();
        norm_mod_phase16(X16, p.g_mlp + l * DM, adal, 3, H, rows2, lane, wid);
        GSYNC();
        { pg8::Gemm g{H, (const bf16*)(wl + WO_1), MLAT, DFF, DM}; pg8::StaticOrder S; S.init(MLAT, DFF, G, bx);
          pg8::EpiSqRelu E{A, DFF};
          for (int rep_ = 0; rep_ < REP_G; ++rep_) pg8::gemm_phase<pg8::EpiSqRelu, pg8::StaticOrder, true, true>(lds, g, S, E); }
        if (!last) { OPAQUE_TID(); sg::EpiSq E{A + (size_t)MLAT * DFF};
          sg::small_gemm<128, sg::EpiSq, 128>(lds, H + (size_t)MLAT * DM, (const bf16*)(wl + WO_1), MTOT - MLAT, DFF, DM, E, tid, lane, wid); }
        GSYNC();
        { pg8::Gemm g{A, (const bf16*)(wl + WO_2), MLAT, DM, DFF}; pg8::StaticOrder S; S.init(MLAT, DM, G, bx);
          pg8::EpiRes E{p.x, p.ctx, X16, X16, adal + 5 * DM};
          pg8::gemm_phase<pg8::EpiRes, pg8::StaticOrder, true, true>(lds, g, S, E); }
        if (!last) { OPAQUE_TID(); sg::EpiPart E{(float*)(ws + WS_PART)};
          sg::small_gemm<128, sg::EpiPart, 128>(lds, A + (size_t)MLAT * DFF, (const bf16*)(wl + WO_2), MTOT - MLAT, DM, DFF, E, tid, lane, wid, 4); }
        GSYNC();
    }
    OPAQUE_TID();
    final_norm_phase(X16, p.g_final, p.out, lane, wid);
}

extern "C" void kernel_launch(void* const* d_in, const int* in_sizes, int n_in, void* d_out, int out_size, void* d_ws, size_t ws_size, hipStream_t stream) {
    static int grid = 0;
    if (grid == 0) {
        if (n_in != 20 || ws_size < WS_END) { fprintf(stderr, "kernel_launch: unexpected n_in %d or ws_size %zu (< %zu)\n", n_in, ws_size, (size_t)WS_END); }
        int dev = 0, cus = 0, per_cu = 0;
        (void)hipGetDevice(&dev);
        (void)hipDeviceGetAttribute(&cus, hipDeviceAttributeMultiprocessorCount, dev);
        (void)hipFuncSetAttribute((const void*)mega_fwd, hipFuncAttributeMaxDynamicSharedMemorySize, LDS_BYTES);
        (void)hipOccupancyMaxActiveBlocksPerMultiprocessor(&per_cu, (const void*)mega_fwd, 512, LDS_BYTES);
        if (per_cu < 1) per_cu = 1;
        grid = cus * per_cu;
        fprintf(stderr, "kernel_launch: grid %d (cus %d x %d)\n", grid, cus, per_cu);
    }
    (void)hipMemsetAsync((unsigned char*)d_ws + WS_BAR, 0, WS_BAR_BYTES, stream);
    Params p{};
    const float** pp = (const float**)&p;
    for (int i = 0; i < 20; ++i) pp[i] = (const float*)d_in[i];
    p.out = (float*)d_out; p.ws = (unsigned char*)d_ws;
    void* args[] = {&p};
    hipError_t e = hipLaunchCooperativeKernel((const void*)mega_fwd, dim3(grid), dim3(512), args, LDS_BYTES, stream);
    if (e != hipSuccess) fprintf(stderr, "cooperative launch failed: %s (grid %d)\n", hipGetErrorString(e), grid);
}
```

```cpp
#include <hip/hip_runtime.h>
#include <hip/hip_cooperative_groups.h>
#include <hip/hip_bf16.h>
#include <cstdio>
#include <cstdint>
namespace cg = cooperative_groups;
#ifndef REP_ATT
#define REP_ATT 1
#endif
#ifndef REP_G
#define REP_G 1
#endif
#ifndef REP_N
#define REP_N 1
#endif
#ifndef REP_SYNC
#define REP_SYNC 1
#endif
#define GSYNC() do { for (int r_ = 0; r_ < REP_SYNC; ++r_) xcd_barrier(xbar); } while (0)
namespace pg8 {
#define PG8_LAS __attribute__((address_space(3)))
typedef unsigned short bf16_t;
typedef short bf16x8 __attribute__((ext_vector_type(8)));
typedef float f32x4 __attribute__((ext_vector_type(4)));
typedef unsigned u32x4 __attribute__((ext_vector_type(4)));
constexpr int BM = 256, BK = 64, HALF = 128, HTB = HALF * BK * 2  , STAGE_BYTES = 8 * HTB, NXCD = 8, WGM = 8;

__host__ __device__ __forceinline__ int lds_byte(int r, int c) { const int st = (r >> 4) * 2 + (c >> 5), rr = r & 15, cc = c & 31, ob = rr * 64 + cc * 2; return st * 1024 + (ob ^ (((ob >> 9) & 1) << 5)); }
__host__ __device__ __forceinline__ void stage_rc(int b, int& R, int& C) { const int st = b / 1024, sb = b % 1024, swz = sb ^ (((sb >> 9) & 1) << 5); R = (st >> 1) * 16 + swz / 64; C = (st & 1) * 32 + (swz % 64) / 2; }
__host__ __device__ __forceinline__ int perm32(int rho) { const int n = rho >> 4, i = rho & 15; return 8 * (i >> 2) + 4 * n + (i & 3); }

struct Unit { int pm, pn; };
struct Gemm { const bf16_t* A; const bf16_t* Bt; int M, N, K; };

struct StaticOrder {
    int nM, nN, nwg, G, c;
    __host__ __device__ void init(int M, int N, int G_, int c_) { nM = M / BM; nN = N / BM; nwg = nM * nN; G = G_; c = c_; }
    __host__ __device__ bool next(int i, Unit& u) const {
        const long L = (long)i * G + c; if (L >= nwg) return false;
        int wgid = (int)L; { const int q = nwg / NXCD, r = nwg % NXCD, xcd = wgid % NXCD, off = wgid / NXCD; wgid = (xcd < r ? xcd * (q + 1) : r * (q + 1) + (xcd - r) * q) + off; }
        const int nig = WGM * nN, gid = wgid / nig, fm = gid * WGM, gsz = (nM - fm) < WGM ? (nM - fm) : WGM;
        u.pm = fm + ((wgid % nig) % gsz); u.pn = (wgid % nig) / gsz; return true;
    }
    __device__ __forceinline__ void a_ready(const Unit&) const {}
    __device__ __forceinline__ void done(const Unit&) const {}
};

__device__ __forceinline__ unsigned cvt_pk_bf16(float lo, float hi) { unsigned r; asm volatile("v_cvt_pk_bf16_f32 %0, %1, %2" : "=v"(r) : "v"(lo), "v"(hi)); return r; }
typedef float f32x2 __attribute__((ext_vector_type(2)));
struct EpiInProj {
    static constexpr bool PERM = true, AFTER_DRAIN = false;
    bf16_t* Z; const float* cosT; const float* sinT;
    __device__ __forceinline__ void operator()(const f32x4 (&acc)[2][2][4][2], const Unit& u, int wr, int wc, int fr, int fq) const {
        const int row0 = u.pm * BM + wr * 64 + fr, colt = u.pn * BM, region = colt >> 9;
        const bool rope = (region == 1 || region == 2) && (u.pm < 64);
        const float sc = (region == 1) ? 0.18033688011112042f : 1.0f;
        const int col0 = colt + wc * 32 + 8 * fq, i0 = (wc & 1) * 16 + 4 * fq;
        f32x4 inv4;
#pragma unroll
        for (int jj = 0; jj < 4; ++jj) inv4[jj] = __builtin_amdgcn_exp2f(-(float)((i0 & 15) + jj) * (13.287712379549449f / 16.0f));
#pragma unroll
        for (int ai = 0; ai < 2; ++ai)
#pragma unroll
            for (int m = 0; m < 4; ++m) {
                const int row = row0 + ai * HALF + m * 16;
                f32x4 cs = (f32x4){1.f, 1.f, 1.f, 1.f}, sn = (f32x4){0.f, 0.f, 0.f, 0.f};
                if (rope) { const int t = row & 4095; const float pos = (float)((i0 < 16) ? (t >> 6) : (t & 63));
#pragma unroll
                    for (int jj = 0; jj < 4; ++jj) { const float ang = pos * inv4[jj]; cs[jj] = __cosf(ang); sn[jj] = __sinf(ang); } }
                bf16_t* rowp = Z + (size_t)row * 2048 + col0;
#pragma unroll
                for (int bj = 0; bj < 2; ++bj) {
                    const f32x4 v0 = acc[ai][bj][m][0], v1 = acc[ai][bj][m][1];
                    f32x4 o0, o1;
                    o0[0] = v0[0] * cs[0] - v0[1] * sn[0]; o0[1] = v0[0] * sn[0] + v0[1] * cs[0];
                    o0[2] = v0[2] * cs[1] - v0[3] * sn[1]; o0[3] = v0[2] * sn[1] + v0[3] * cs[1];
                    o1[0] = v1[0] * cs[2] - v1[1] * sn[2]; o1[1] = v1[0] * sn[2] + v1[1] * cs[2];
                    o1[2] = v1[2] * cs[3] - v1[3] * sn[3]; o1[3] = v1[2] * sn[3] + v1[3] * cs[3];
                    o0 = o0 * sc; o1 = o1 * sc;
                    u32x4 w; w.x = cvt_pk_bf16(o0[0], o0[1]); w.y = cvt_pk_bf16(o0[2], o0[3]); w.z = cvt_pk_bf16(o1[0], o1[1]); w.w = cvt_pk_bf16(o1[2], o1[3]);
                    *(u32x4*)(rowp + bj * HALF) = w;
                }
            }
    }
};
struct EpiSqRelu {
    static constexpr bool PERM = true, AFTER_DRAIN = false;
    bf16_t* O; int ldc;
    __device__ __forceinline__ void operator()(const f32x4 (&acc)[2][2][4][2], const Unit& u, int wr, int wc, int fr, int fq) const {
        const int row0 = u.pm * BM + wr * 64 + fr, col0 = u.pn * BM + wc * 32 + 8 * fq;
#pragma unroll
        for (int ai = 0; ai < 2; ++ai)
#pragma unroll
            for (int m = 0; m < 4; ++m) { bf16_t* rowp = O + (size_t)(row0 + ai * HALF + m * 16) * ldc + col0;
#pragma unroll
                for (int bj = 0; bj < 2; ++bj) { f32x4 v0 = acc[ai][bj][m][0], v1 = acc[ai][bj][m][1];
#pragma unroll
                    for (int j = 0; j < 4; ++j) { const float a = fmaxf(v0[j], 0.f), b = fmaxf(v1[j], 0.f); v0[j] = a * a; v1[j] = b * b; }
                    u32x4 w; w.x = cvt_pk_bf16(v0[0], v0[1]); w.y = cvt_pk_bf16(v0[2], v0[3]); w.z = cvt_pk_bf16(v1[0], v1[1]); w.w = cvt_pk_bf16(v1[2], v1[3]);
                    *(u32x4*)(rowp + bj * HALF) = w; } }
    }
};
struct EpiRes {
    static constexpr bool PERM = true, AFTER_DRAIN = false;
    const float* res_lat32; const float* res_ctx32; const bf16_t* res16; bf16_t* out16; const float* gate;
    __device__ __forceinline__ void operator()(const f32x4 (&acc)[2][2][4][2], const Unit& u, int wr, int wc, int fr, int fq) const {
        const int row0 = u.pm * BM + wr * 64 + fr, col0 = u.pn * BM + wc * 32 + 8 * fq;
        const bool lat = u.pm < 64; const int b = lat ? (u.pm >> 4) : 4;
        const float* gp = gate + (size_t)b * 6144 + col0;
        f32x4 gv[2][2];
#pragma unroll
        for (int bj = 0; bj < 2; ++bj)
#pragma unroll
            for (int n = 0; n < 2; ++n) gv[bj][n] = *(const f32x4*)(gp + bj * HALF + 4 * n);
#pragma unroll
        for (int ai = 0; ai < 2; ++ai)
#pragma unroll
            for (int m = 0; m < 4; ++m) { const int row = row0 + ai * HALF + m * 16;
                bf16_t* op = out16 + (size_t)row * 1024 + col0;
#pragma unroll
                for (int bj = 0; bj < 2; ++bj) { f32x4 r0, r1;
                    if (res16) { const u32x4 q = *(const u32x4*)(res16 + (size_t)row * 1024 + col0 + bj * HALF);
                        r0 = (f32x4){__builtin_bit_cast(float, q.x << 16), __builtin_bit_cast(float, q.x & 0xffff0000u), __builtin_bit_cast(float, q.y << 16), __builtin_bit_cast(float, q.y & 0xffff0000u)};
                        r1 = (f32x4){__builtin_bit_cast(float, q.z << 16), __builtin_bit_cast(float, q.z & 0xffff0000u), __builtin_bit_cast(float, q.w << 16), __builtin_bit_cast(float, q.w & 0xffff0000u)}; }
                    else { const float* rp = (lat ? res_lat32 + (size_t)row * 1024 : res_ctx32 + (size_t)(row - 16384) * 1024) + col0 + bj * HALF;
                        r0 = *(const f32x4*)rp; r1 = *(const f32x4*)(rp + 4); }
                    const f32x4 o0 = r0 + gv[bj][0] * acc[ai][bj][m][0], o1 = r1 + gv[bj][1] * acc[ai][bj][m][1];
                    u32x4 w; w.x = cvt_pk_bf16(o0[0], o0[1]); w.y = cvt_pk_bf16(o0[2], o0[3]); w.z = cvt_pk_bf16(o1[0], o1[1]); w.w = cvt_pk_bf16(o1[2], o1[3]);
                    *(u32x4*)(op + bj * HALF) = w; } }
    }
};
template <class Epi, class Sched, bool ALIGN_EPI = false, bool SP2 = false>
__device__ __forceinline__ void gemm_phase(PG8_LAS unsigned char* lds, const Gemm g, const Sched& S, const Epi& E) {
    int tid = threadIdx.x; asm volatile("" : "+v"(tid));
    const int wid = __builtin_amdgcn_readfirstlane(tid >> 6), lane = tid & 63, wr = wid >> 2, wc = wid & 3, fr = lane & 15, fq = lane >> 4;
    const int K = g.K, nt = K / BK;
    unsigned voffA[2], voffB[2];
#pragma unroll
    for (int i = 0; i < 2; ++i) { int R, C; stage_rc(tid * 16 + i * 8192, R, C); const int Rb = Epi::PERM ? ((R & ~31) + perm32(R & 31)) : R;
        voffA[i] = (unsigned)(R * K + C) * 2u; voffB[i] = (unsigned)(Rb * K + C) * 2u; }
    const size_t kstep = (size_t)(BK * 2);
    const size_t hstep = (size_t)HALF * K * 2;
    const size_t tstep = 2 * hstep;
    const unsigned ldsw = (unsigned)wid * 1024u;
    const int aoff = lds_byte(wr * 64 + fr, fq * 8), boff = lds_byte(wc * 32 + fr, fq * 8);
#define PG8_SA(b, h) (((b) * 2 + (h)) * HTB)
#define PG8_SB(b, h) ((4 + (b) * 2 + (h)) * HTB)
#define PG8_STAGE(bufoff, gbase, voff) do { _Pragma("unroll") for (int _i = 0; _i < 2; ++_i) \
        __builtin_amdgcn_global_load_lds((const unsigned*)((const char*)(gbase) + (voff)[_i]), (PG8_LAS unsigned*)(lds + (bufoff) + ldsw + _i * 8192), 16, 0, 0); } while (0)
#define PG8_LDA(dst, b, h) do { _Pragma("unroll") for (int m = 0; m < 4; ++m) _Pragma("unroll") for (int k = 0; k < 2; ++k) dst[m][k] = *(const PG8_LAS bf16x8*)(lds + PG8_SA(b, h) + aoff + m * 2048 + k * 1024); } while (0)
#define PG8_LDB(dst, b, h) do { _Pragma("unroll") for (int n = 0; n < 2; ++n) _Pragma("unroll") for (int k = 0; k < 2; ++k) dst[n][k] = *(const PG8_LAS bf16x8*)(lds + PG8_SB(b, h) + boff + n * 2048 + k * 1024); } while (0)
#define PG8_MMA(ai, bj, At, Bt) do { __builtin_amdgcn_s_setprio(1); _Pragma("unroll") for (int m = 0; m < 4; ++m) _Pragma("unroll") for (int n = 0; n < 2; ++n) _Pragma("unroll") for (int k = 0; k < 2; ++k) \
        acc[ai][bj][m][n] = __builtin_amdgcn_mfma_f32_16x16x32_bf16(Bt[n][k], At[m][k], acc[ai][bj][m][n], 0, 0, 0); __builtin_amdgcn_s_setprio(0); } while (0)
#define PG8_WAIT_V(n) asm volatile("s_waitcnt vmcnt(" #n ")" ::: "memory")
#define PG8_WAIT_L(n) asm volatile("s_waitcnt lgkmcnt(" #n ")" ::: "memory")
#define PG8_BAR __builtin_amdgcn_s_barrier()
#define PG8_SCHED __builtin_amdgcn_sched_barrier(0)
    Unit cur, nxt; int ui = 0;
    if (!S.next(0, cur)) return;
    f32x4 acc[2][2][4][2];
#pragma unroll
    for (int a = 0; a < 2; ++a)
#pragma unroll
        for (int b = 0; b < 2; ++b)
#pragma unroll
            for (int m = 0; m < 4; ++m)
#pragma unroll
                for (int n = 0; n < 2; ++n) acc[a][b][m][n] = (f32x4){0.f, 0.f, 0.f, 0.f};
    bf16x8 At[4][2], B0[2][2], B1[2][2];
    const char* cA = (const char*)g.A + (size_t)cur.pm * tstep; const char* cB = (const char*)g.Bt + (size_t)cur.pn * tstep;
    S.a_ready(cur);
    if constexpr (SP2) {
        PG8_STAGE(PG8_SB(0, 0), cB, voffB); PG8_STAGE(PG8_SB(0, 1), cB + hstep, voffB); PG8_STAGE(PG8_SA(0, 0), cA, voffA); PG8_STAGE(PG8_SA(0, 1), cA + hstep, voffA);
        if (wr == 1) PG8_BAR;
        PG8_WAIT_V(2); PG8_BAR;
        PG8_STAGE(PG8_SB(1, 0), cB + kstep, voffB); PG8_STAGE(PG8_SA(1, 0), cA + kstep, voffA); PG8_STAGE(PG8_SB(1, 1), cB + hstep + kstep, voffB);
        PG8_WAIT_V(6); PG8_BAR;
    } else {
        PG8_STAGE(PG8_SB(0, 0), cB, voffB); PG8_STAGE(PG8_SA(0, 0), cA, voffA); PG8_STAGE(PG8_SB(0, 1), cB + hstep, voffB); PG8_STAGE(PG8_SA(0, 1), cA + hstep, voffA);
        if (wr == 1) PG8_BAR;
        PG8_WAIT_V(4); PG8_BAR;
        PG8_STAGE(PG8_SB(1, 0), cB + kstep, voffB); PG8_STAGE(PG8_SA(1, 0), cA + kstep, voffA); PG8_STAGE(PG8_SB(1, 1), cB + hstep + kstep, voffB);
        PG8_WAIT_V(6); PG8_BAR;
    }
    for (;;) {
        const bool has_next = S.next(ui + 1, nxt);
        const char* nA = has_next ? (const char*)g.A + (size_t)nxt.pm * tstep : cA; const char* nB = has_next ? (const char*)g.Bt + (size_t)nxt.pn * tstep : cB;
        for (int t = 0; t < nt; t += 2) {
            const bool last = (t == nt - 2);
            const char* a1 = cA + (size_t)(t + 1) * kstep;
            const char* a2 = last ? nA : cA + (size_t)(t + 2) * kstep; const char* b2 = last ? nB : cB + (size_t)(t + 2) * kstep;
            const char* a3 = a2 + kstep; const char* b3 = b2 + kstep;
            if (last && has_next) S.a_ready(nxt);
            if constexpr (SP2) {
            PG8_LDB(B0, 0, 0); PG8_LDB(B1, 0, 1); PG8_SCHED; PG8_LDA(At, 0, 0); PG8_STAGE(PG8_SA(1, 1), a1 + hstep, voffA);
            PG8_WAIT_V(8); PG8_WAIT_L(0); PG8_BAR; PG8_MMA(0, 0, At, B0); PG8_MMA(0, 1, At, B1); PG8_BAR; PG8_SCHED;
            PG8_LDA(At, 0, 1); PG8_STAGE(PG8_SB(0, 0), b2, voffB); PG8_STAGE(PG8_SB(0, 1), b2 + hstep, voffB); PG8_STAGE(PG8_SA(0, 0), a2, voffA);
            PG8_WAIT_V(8); PG8_WAIT_L(0); PG8_BAR; PG8_MMA(1, 0, At, B0); PG8_MMA(1, 1, At, B1); PG8_BAR; PG8_SCHED;
            PG8_LDB(B0, 1, 0); PG8_LDB(B1, 1, 1); PG8_SCHED; PG8_LDA(At, 1, 0); PG8_STAGE(PG8_SA(0, 1), a2 + hstep, voffA);
            PG8_WAIT_V(8); PG8_WAIT_L(0); PG8_BAR; PG8_MMA(0, 0, At, B0); PG8_MMA(0, 1, At, B1); PG8_BAR; PG8_SCHED;
            PG8_LDA(At, 1, 1); PG8_STAGE(PG8_SB(1, 0), b3, voffB); PG8_STAGE(PG8_SB(1, 1), b3 + hstep, voffB); PG8_STAGE(PG8_SA(1, 0), a3, voffA);
            PG8_WAIT_V(8); PG8_WAIT_L(0); PG8_BAR; PG8_MMA(1, 0, At, B0); PG8_MMA(1, 1, At, B1); PG8_BAR; PG8_SCHED;
            } else {
            PG8_LDB(B0, 0, 0); PG8_SCHED; PG8_LDA(At, 0, 0); PG8_STAGE(PG8_SA(1, 1), a1 + hstep, voffA);
            PG8_WAIT_L(8); PG8_BAR; PG8_WAIT_L(0); PG8_MMA(0, 0, At, B0); PG8_BAR; PG8_SCHED;
            PG8_LDB(B1, 0, 1); PG8_STAGE(PG8_SB(0, 0), b2, voffB);
            PG8_BAR; PG8_WAIT_L(0); PG8_MMA(0, 1, At, B1); PG8_BAR;
            PG8_LDA(At, 0, 1); PG8_STAGE(PG8_SA(0, 0), a2, voffA);
            PG8_BAR; PG8_WAIT_L(0); PG8_MMA(1, 0, At, B0); PG8_BAR; PG8_SCHED;
            PG8_STAGE(PG8_SB(0, 1), b2 + hstep, voffB);
            PG8_WAIT_V(6); PG8_BAR; PG8_MMA(1, 1, At, B1); PG8_BAR;
            PG8_LDB(B0, 1, 0); PG8_SCHED; PG8_LDA(At, 1, 0); PG8_STAGE(PG8_SA(0, 1), a2 + hstep, voffA);
            PG8_WAIT_L(8); PG8_BAR; PG8_WAIT_L(0); PG8_MMA(0, 0, At, B0); PG8_BAR; PG8_SCHED;
            PG8_LDB(B1, 1, 1); PG8_STAGE(PG8_SB(1, 0), b3, voffB);
            PG8_BAR; PG8_WAIT_L(0); PG8_MMA(0, 1, At, B1); PG8_BAR;
            PG8_LDA(At, 1, 1); PG8_STAGE(PG8_SA(1, 0), a3, voffA);
            PG8_BAR; PG8_WAIT_L(0); PG8_MMA(1, 0, At, B0); PG8_BAR; PG8_SCHED;
            PG8_STAGE(PG8_SB(1, 1), b3 + hstep, voffB);
            PG8_WAIT_V(6); PG8_BAR; PG8_MMA(1, 1, At, B1); PG8_BAR;
            }
        }
        if constexpr (ALIGN_EPI) { if (wr == 0) PG8_BAR; }
        if constexpr (!Epi::AFTER_DRAIN) { E(acc, cur, wr, wc, fr, fq); S.done(cur); }
        if (!has_next) break;
#pragma unroll
        for (int a = 0; a < 2; ++a)
#pragma unroll
            for (int b = 0; b < 2; ++b)
#pragma unroll
                for (int m = 0; m < 4; ++m)
#pragma unroll
                    for (int n = 0; n < 2; ++n) acc[a][b][m][n] = (f32x4){0.f, 0.f, 0.f, 0.f};
        cur = nxt; cA = nA; cB = nB; ++ui;
        if constexpr (ALIGN_EPI) { if (wr == 1) PG8_BAR; }
    }
    PG8_WAIT_V(0);
    if constexpr (!ALIGN_EPI) { if (wr == 0) PG8_BAR; }
    PG8_BAR;
    if constexpr (Epi::AFTER_DRAIN) { E.fused(acc, cur, wr, wc, fr, fq, lds, wid, lane); S.done(cur); }
#undef PG8_SA
#undef PG8_SB
#undef PG8_STAGE
#undef PG8_LDA
#undef PG8_LDB
#undef PG8_MMA
#undef PG8_WAIT_V
#undef PG8_WAIT_L
#undef PG8_BAR
#undef PG8_SCHED
}
}

#define LAS __attribute__((address_space(3)))
typedef unsigned short bf16;
typedef unsigned v4u __attribute__((ext_vector_type(4)));
typedef unsigned v2u __attribute__((ext_vector_type(2)));
typedef float f32x4 __attribute__((ext_vector_type(4)));
typedef float f32x2 __attribute__((ext_vector_type(2)));
typedef float f32x16 __attribute__((ext_vector_type(16)));
typedef short bf16x8 __attribute__((ext_vector_type(8)));
typedef short s16x4 __attribute__((ext_vector_type(4)));

constexpr int DM = 1024, SEQ = 4096, CTXL = 256, NBATCH = 4, MLAT = 16384, MTOT = 17408, INW = 2048, DFF = 4096, NLAYER = 4, NADA = 6144;
constexpr size_t MiB = 1u << 20;
constexpr size_t WS_BAR = 512 * 1024, WS_BAR_BYTES = 16384;
constexpr size_t WS_ADA = 0, WS_ROPE = 1 * MiB, WS_W = 2 * MiB, W_LAYER = 23 * MiB;
constexpr size_t WO_IN = 0, WO_OUT = 4 * MiB, WO_1 = 6 * MiB, WO_2 = 14 * MiB, WO_P = 22 * MiB;
constexpr size_t WS_X = 94 * MiB, WS_H = 162 * MiB, WS_Z = 196 * MiB, WS_MIX = 264 * MiB, WS_A = 196 * MiB, WS_PART = 332 * MiB, WS_END = 348 * MiB;
constexpr int LDS_BYTES = 147456, LDS_CTL = 143360;
constexpr int NWAVES = 8;

struct Params {
    const float *x, *c, *ctx, *c_ctx, *w_ada, *b_ada, *g_mix, *g_mlp, *w_in, *w_pool, *s_pool, *lq1, *lk1, *lq2, *lk2, *g_sub, *w_out, *w1, *w2, *g_final;
    float* out; unsigned char* ws;
};

__device__ __forceinline__ unsigned f2bf(float f) { unsigned u = __builtin_bit_cast(unsigned, f); return (u + 0x7fffu + ((u >> 16) & 1u)) >> 16; }
__device__ __forceinline__ unsigned pk2(float lo, float hi) { return f2bf(lo) | (f2bf(hi) << 16); }
__device__ __forceinline__ float bf2f(unsigned short v) { return __builtin_bit_cast(float, (unsigned)v << 16); }
__device__ __forceinline__ float shfl_xor_l(float v, int mask, int lane) { return __builtin_bit_cast(float, __builtin_amdgcn_ds_bpermute((lane ^ mask) << 2, __builtin_bit_cast(int, v))); }
__device__ __forceinline__ float wave_sum(float v, int lane) {
#define WS_ROR(n_) __builtin_bit_cast(float, __builtin_amdgcn_update_dpp(0, __builtin_bit_cast(int, v), 0x120 + (n_), 0xf, 0xf, false))
    v += WS_ROR(8); v += WS_ROR(4); v += WS_ROR(2); v += WS_ROR(1);
#undef WS_ROR
    v += shfl_xor_l(v, 16, lane); v += shfl_xor_l(v, 32, lane);
    return v;
}

__device__ __forceinline__ int inproj_dest(int n) { if (n < 512 || n >= 1536) return n; const int p = n & 63, nb = n - p; return nb + 2 * (p & 31) + (p >> 5); }
template <bool PERMQK>
__device__ __forceinline__ void transpose_item(const float* W, int K, int N, bf16* WT, LAS float* scr, int item, int lane) {
    const int nblk = N / 32, kb = item / nblk, nb = item % nblk, k0 = 64 * kb, n0 = 32 * nb;
    { const int kr = lane >> 3, c4 = lane & 7;
      f32x4 tv[8];
#pragma unroll
      for (int i = 0; i < 8; ++i) tv[i] = *(const f32x4*)(W + (size_t)(k0 + 8 * i + kr) * N + n0 + 4 * c4);
#pragma unroll
      for (int i = 0; i < 8; ++i) { LAS float* d = scr + (8 * i + kr) * 33 + 4 * c4; d[0] = tv[i].x; d[1] = tv[i].y; d[2] = tv[i].z; d[3] = tv[i].w; } }
    asm volatile("s_waitcnt lgkmcnt(0)" ::: "memory");
    const int c = lane & 7;
#pragma unroll
    for (int j = 0; j < 4; ++j) { const int n = (lane >> 3) + 8 * j; const LAS float* s = scr + (8 * c) * 33 + n;
        v4u o; o.x = pk2(s[0 * 33], s[1 * 33]); o.y = pk2(s[2 * 33], s[3 * 33]); o.z = pk2(s[4 * 33], s[5 * 33]); o.w = pk2(s[6 * 33], s[7 * 33]);
        const int nd = PERMQK ? inproj_dest(n0 + n) : (n0 + n);
        *(v4u*)(WT + (size_t)nd * K + k0 + 8 * c) = o; }
    asm volatile("s_waitcnt lgkmcnt(0)" ::: "memory");
}

__device__ __forceinline__ void prologue(const Params& p, LAS unsigned char* lds, int tid, int lane, int wid) {
    const int G = gridDim.x, bx = blockIdx.x;
    float* ada = (float*)(p.ws + WS_ADA);
    if (bx < 192) {
        LAS float* S = (LAS float*)lds;
        LAS float* P = (LAS float*)(lds + 20480);
        for (int idx = tid; idx < 5 * 1024; idx += 512) { const int r = idx >> 10, k = idx & 1023; const float v = (r < 4) ? p.c[r * 1024 + k] : p.c_ctx[k]; S[idx] = v / (1.f + __expf(-v)); }
        __syncthreads();
        for (int it = bx; it < 192; it += G) {
            const int l = it / 48, j0 = (it % 48) * 128;
            const float* wp = p.w_ada + ((size_t)l * 1024 + wid * 128) * NADA + j0 + 2 * lane;
            f32x2 a0 = {0.f, 0.f}, a1 = a0, a2 = a0, a3 = a0, a4 = a0;
#pragma unroll 16
            for (int k = 0; k < 128; ++k) { const f32x2 w = *(const f32x2*)(wp + (size_t)k * NADA); const int kk = wid * 128 + k;
                a0 += w * S[kk]; a1 += w * S[1024 + kk]; a2 += w * S[2048 + kk]; a3 += w * S[3072 + kk]; a4 += w * S[4096 + kk]; }
            LAS float* pw = P + wid * 640 + 2 * lane;
            *(LAS f32x2*)(pw) = a0; *(LAS f32x2*)(pw + 128) = a1; *(LAS f32x2*)(pw + 256) = a2; *(LAS f32x2*)(pw + 384) = a3; *(LAS f32x2*)(pw + 512) = a4;
            __syncthreads();
            for (int o = tid; o < 640; o += 512) { const int r = o >> 7, j = o & 127; float s = p.b_ada[l * NADA + j0 + j];
#pragma unroll
                for (int w = 0; w < 8; ++w) s += P[w * 640 + o];
                ada[((size_t)l * 5 + r) * NADA + j0 + j] = s; }
            __syncthreads();
        }
    }
    __syncthreads();
    {
        float* cosT = (float*)(p.ws + WS_ROPE); float* sinT = cosT + 4096 * 32;
        for (int idx = bx * 512 + tid; idx < 4096 * 32; idx += G * 512) { const int t = idx >> 5, i = idx & 31;
            const float inv = exp2f(-(float)(i & 15) * (13.287712379549449f / 16.0f));
            const float ang = (float)((i < 16) ? (t >> 6) : (t & 63)) * inv;
            cosT[idx] = __cosf(ang); sinT[idx] = __sinf(ang); }
    }
    {
        LAS float* scr = (LAS float*)(lds + wid * 16384);
        const int gw = bx * NWAVES + wid, NGW = G * NWAVES;
        constexpr int I_IN = 16 * 64, I_OUT = 16 * 32, I_1 = 16 * 128, I_2 = 64 * 32, I_P = 4 * 8, I_L = I_IN + I_OUT + I_1 + I_2 + I_P;
        for (int it = gw; it < NLAYER * I_L; it += NGW) {
            const int l = it / I_L; int r = it % I_L;
            unsigned char* wl = p.ws + WS_W + (size_t)l * W_LAYER;
            if (r < I_IN) { transpose_item<true>(p.w_in + (size_t)l * DM * INW, DM, INW, (bf16*)(wl + WO_IN), scr, r, lane); continue; } r -= I_IN;
            if (r < I_OUT) { transpose_item<false>(p.w_out + (size_t)l * DM * DM, DM, DM, (bf16*)(wl + WO_OUT), scr, r, lane); continue; } r -= I_OUT;
            if (r < I_1) { transpose_item<false>(p.w1 + (size_t)l * DM * DFF, DM, DFF, (bf16*)(wl + WO_1), scr, r, lane); continue; } r -= I_1;
            if (r < I_2) { transpose_item<false>(p.w2 + (size_t)l * DFF * DM, DFF, DM, (bf16*)(wl + WO_2), scr, r, lane); continue; } r -= I_2;
            { const int g = r >> 3; transpose_item<false>(p.w_pool + ((size_t)l * 4 + g) * 128 * 128, 128, 128, (bf16*)(wl + WO_P) + g * 16384, scr, r & 7, lane); }
        }
    }
}

#define NORM_ROWS_BEGIN() const int gw = blockIdx.x * NWAVES + wid, NGW = gridDim.x * NWAVES; \
    int q_ = 0; while ((q_ + 1) * NGW <= nrows) ++q_;                         \
    const int rem_ = nrows - q_ * NGW, r0 = gw * q_ + (gw < rem_ ? gw : rem_), r1 = r0 + q_ + (gw < rem_ ? 1 : 0)
#define NORM_LOAD_MOD(b_) do { const f32x4* gp_ = (const f32x4*)g + lane; const f32x4* sh_ = (const f32x4*)(adal + (size_t)(b_) * NADA + shift_idx * DM) + lane; \
        const f32x4* sc_ = (const f32x4*)(adal + (size_t)(b_) * NADA + (shift_idx + 1) * DM) + lane; \
        _Pragma("unroll") for (int j = 0; j < 4; ++j) { Gm[j] = gp_[64 * j] * (sc_[64 * j] + 1.0f); Sh[j] = sh_[64 * j]; } } while (0)
__device__ __forceinline__ void norm_mod_phase(const float* src_lat, const float* src_ctx, const float* g, const float* adal, int shift_idx, bf16* H, int nrows, int lane, int wid) {
    NORM_ROWS_BEGIN();
    int bcur = -1; f32x4 Gm[4], Sh[4];
    for (int row = r0; row < r1; ++row) {
        const bool lat = row < MLAT; const int b = lat ? (row >> 12) : 4;
        if (b != bcur) { NORM_LOAD_MOD(b); bcur = b; }
        const f32x4* xr = (const f32x4*)(lat ? src_lat + (size_t)row * DM : src_ctx + (size_t)(row - MLAT) * DM) + lane;
        f32x4 v[4]; float s = 0.f;
#pragma unroll
        for (int j = 0; j < 4; ++j) { v[j] = xr[64 * j]; s += (v[j].x * v[j].x + v[j].y * v[j].y) + (v[j].z * v[j].z + v[j].w * v[j].w); }
        const float rinv = 1.0f / sqrtf(wave_sum(s, lane) * (1.f / DM) + 1e-6f);
        unsigned long long* o8 = (unsigned long long*)(H + (size_t)row * DM) + lane;
#pragma unroll
        for (int j = 0; j < 4; ++j) { const f32x4 y = v[j] * rinv * Gm[j] + Sh[j];
            o8[64 * j] = (unsigned long long)pk2(y.x, y.y) | ((unsigned long long)pk2(y.z, y.w) << 32); }
    }
}
__device__ __forceinline__ f32x4 unpack4(v2u q) { return (f32x4){__builtin_bit_cast(float, q.x << 16), __builtin_bit_cast(float, q.x & 0xffff0000u), __builtin_bit_cast(float, q.y << 16), __builtin_bit_cast(float, q.y & 0xffff0000u)}; }
__device__ __forceinline__ void norm_mod_phase16(bf16* X16, const float* g, const float* adal, int shift_idx, bf16* H, int nrows, int lane, int wid, const float* part = nullptr, const float* pgate = nullptr) {
    NORM_ROWS_BEGIN();
    int bcur = -1; f32x4 Gm[4], Sh[4];
    for (int rowa = r0; rowa < r1; rowa += 3) {
        v2u q[3][4];
#pragma unroll
        for (int r = 0; r < 3; ++r) { const int row = (rowa + r < r1) ? rowa + r : rowa; const v2u* xr = (const v2u*)(X16 + (size_t)row * DM) + lane;
#pragma unroll
            for (int j = 0; j < 4; ++j) q[r][j] = xr[64 * j]; }
#pragma unroll
        for (int r = 0; r < 3; ++r) { const int row = rowa + r; if (row < r1) {
            const int b = row < MLAT ? (row >> 12) : 4;
            if (b != bcur) { NORM_LOAD_MOD(b); bcur = b; }
            f32x4 v[4]; float s = 0.f;
#pragma unroll
            for (int j = 0; j < 4; ++j) v[j] = unpack4(q[r][j]);
            if (part != nullptr && row >= MLAT) {
                const f32x4* pp = (const f32x4*)(part + (size_t)(row - MLAT) * DM) + lane; const f32x4* pg = (const f32x4*)pgate + lane;
#pragma unroll
                for (int j = 0; j < 4; ++j) { const f32x4 t = (pp[64 * j] + pp[64 * j + 262144]) + (pp[64 * j + 2 * 262144] + pp[64 * j + 3 * 262144]);
                    v[j] += pg[64 * j] * t;
                    v2u w; w.x = pk2(v[j].x, v[j].y); w.y = pk2(v[j].z, v[j].w); ((v2u*)(X16 + (size_t)row * DM) + lane)[64 * j] = w;
                    v[j] = unpack4(w); }
            }
#pragma unroll
            for (int j = 0; j < 4; ++j) s += (v[j].x * v[j].x + v[j].y * v[j].y) + (v[j].z * v[j].z + v[j].w * v[j].w);
            const float rinv = 1.0f / sqrtf(wave_sum(s, lane) * (1.f / DM) + 1e-6f);
            unsigned long long* o8 = (unsigned long long*)(H + (size_t)row * DM) + lane;
#pragma unroll
            for (int j = 0; j < 4; ++j) { const f32x4 y = v[j] * rinv * Gm[j] + Sh[j];
                o8[64 * j] = (unsigned long long)pk2(y.x, y.y) | ((unsigned long long)pk2(y.z, y.w) << 32); } } }
    }
}
__device__ __forceinline__ void final_norm_phase(const bf16* X16, const float* g, float* out, int lane, int wid) {
    const int nrows = MLAT;
    NORM_ROWS_BEGIN();
    f32x4 Gm[4];
    { const f32x4* gp = (const f32x4*)g + lane;
#pragma unroll
      for (int j = 0; j < 4; ++j) Gm[j] = gp[64 * j]; }
    for (int row = r0; row < r1; ++row) {
        const v2u* xr = (const v2u*)(X16 + (size_t)row * DM) + lane;
        f32x4 v[4]; float s = 0.f;
#pragma unroll
        for (int j = 0; j < 4; ++j) { v[j] = unpack4(xr[64 * j]); s += (v[j].x * v[j].x + v[j].y * v[j].y) + (v[j].z * v[j].z + v[j].w * v[j].w); }
        const float rinv = 1.0f / sqrtf(wave_sum(s, lane) * (1.f / DM) + 1e-6f);
        f32x4* o = (f32x4*)(out + (size_t)row * DM) + lane;
#pragma unroll
        for (int j = 0; j < 4; ++j) o[64 * j] = v[j] * rinv * Gm[j];
    }
}
#undef NORM_ROWS_BEGIN
#undef NORM_LOAD_MOD

constexpr int POOL_PITCH = 1040;
__device__ __forceinline__ void pool_unit(LAS unsigned char* lds, const bf16* Z, bf16* MIX, const bf16* WpT, const float* spool, int tt, int tid, int lane, int wid) {
    const int row0 = tt * 64;
    int seq0, n; if (row0 < MLAT) { seq0 = row0 & ~4095; n = SEQ; } else { seq0 = MLAT + ((row0 - MLAT) & ~255); n = CTXL; }
    const int t0 = row0 - seq0;
    v4u uv[10];
#pragma unroll
    for (int i = 0; i < 10; ++i) { const int r = wid + 8 * i, tok = t0 - 8 + r; uv[i] = (v4u){0u, 0u, 0u, 0u};
        if (r < 79 && tok >= 0 && tok < n) uv[i] = *(const v4u*)(Z + (size_t)(seq0 + tok) * INW + lane * 8); }
    const int g = wid >> 1, dbase = (wid & 1) * 64, fr = lane & 15, fq = lane >> 4;
    bf16x8 af[4][4];
    { const bf16* Wg = WpT + g * 16384;
#pragma unroll
      for (int kk = 0; kk < 4; ++kk)
#pragma unroll
          for (int mi = 0; mi < 4; ++mi) af[kk][mi] = *(const bf16x8*)(Wg + (dbase + 16 * mi + fr) * 128 + 32 * kk + 8 * fq); }
#pragma unroll
    for (int i = 0; i < 10; ++i) { const int r = wid + 8 * i; if (r < 79) *(LAS v4u*)(lds + r * POOL_PITCH + lane * 16) = uv[i]; }
    __syncthreads();
    {
        const int cp = tid & 255, th = tid >> 8, gg = cp >> 6, w = 2 << gg, lo = w >> 1, hiw = (w >> 1) - 1;
        LAS unsigned* colw = (LAS unsigned*)lds + cp;
        constexpr int RW = POOL_PITCH / 4;
        const int ts = 32 * th;
        float s0 = 0.f, s1 = 0.f;
        for (int r = ts + 8 - lo; r <= ts + 8 + hiw; ++r) { const unsigned q = colw[r * RW]; s0 += __builtin_bit_cast(float, q << 16); s1 += __builtin_bit_cast(float, q & 0xffff0000u); }
        for (int i = 0; i < 32; ++i) { const int t = ts + i;
            const int tok = t0 + t; const int a = max(tok - lo, 0), e = min(tok + hiw, n - 1);
            const float rc = 1.0f / (float)(e - a + 1);
            const unsigned qo = colw[(t + 8 - lo) * RW], qi = colw[(t + 8) * RW];
            const float y0 = s0 * rc - __builtin_bit_cast(float, qi << 16), y1 = s1 * rc - __builtin_bit_cast(float, qi & 0xffff0000u);
            colw[(th ? 47 + t : t) * RW] = pk2(y0, y1);
            if (i < 31) { const unsigned qn = colw[(t + 9 + hiw) * RW];
                s0 += __builtin_bit_cast(float, qn << 16) - __builtin_bit_cast(float, qo << 16); s1 += __builtin_bit_cast(float, qn & 0xffff0000u) - __builtin_bit_cast(float, qo & 0xffff0000u); }
        }
    }
    __syncthreads();
    {
        f32x4 acc[4][4];
#pragma unroll
        for (int a = 0; a < 4; ++a)
#pragma unroll
            for (int b = 0; b < 4; ++b) acc[a][b] = (f32x4){0.f, 0.f, 0.f, 0.f};
#pragma unroll
        for (int kk = 0; kk < 4; ++kk) {
            bf16x8 bfr[4];
#pragma unroll
            for (int ni = 0; ni < 4; ++ni) { const int rowi = (ni < 2) ? 16 * ni + fr : 47 + 16 * ni + fr;
                bfr[ni] = *(const LAS bf16x8*)(lds + rowi * POOL_PITCH + (128 * g + 32 * kk + 8 * fq) * 2); }
#pragma unroll
            for (int mi = 0; mi < 4; ++mi)
#pragma unroll
                for (int ni = 0; ni < 4; ++ni) acc[mi][ni] = __builtin_amdgcn_mfma_f32_16x16x32_bf16(af[kk][mi], bfr[ni], acc[mi][ni], 0, 0, 0);
        }
#pragma unroll
        for (int mi = 0; mi < 4; ++mi) { const int d0 = dbase + 16 * mi + 4 * fq; const f32x4 sp = *(const f32x4*)(spool + 128 * g + d0);
#pragma unroll
            for (int ni = 0; ni < 4; ++ni) { const int t = 16 * ni + fr; const f32x4 v = acc[mi][ni] * sp;
                v2u w; w.x = pk2(v.x, v.y); w.y = pk2(v.z, v.w);
                *(v2u*)(MIX + (size_t)(row0 + t) * DM + 128 * g + d0) = w; } }
    }
    __syncthreads();
}

namespace att {
constexpr int BUF = 32768, K1_OFF = 0, K2_OFF = 8192, V_OFF = 16384, SCR_OFF = 4 * 32768;
__device__ __forceinline__ void glds16(const void* gsrc, unsigned lds_dst) { unsigned keep;
    asm volatile("s_mov_b32 %0, m0\n\ts_mov_b32 m0, %2\n\ts_nop 0\n\tglobal_load_lds_dwordx4 %1, off\n\ts_mov_b32 m0, %0" : "=&s"(keep) : "v"(gsrc), "s"(lds_dst) : "memory"); }
typedef short v4i16_t __attribute__((ext_vector_type(4)));
__device__ __forceinline__ int crow(int r, int hi) { return (r & 3) + 8 * (r >> 2) + 4 * hi; }
__device__ __forceinline__ bf16x8 pack8(const f32x16& x, int s) {
    typedef __bf16 bf16x2_t __attribute__((ext_vector_type(2)));
    v4u p;
#pragma unroll
    for (int j = 0; j < 4; ++j) { f32x2 v = {x[8 * s + 2 * j], x[8 * s + 2 * j + 1]}; bf16x2_t b = __builtin_convertvector(v, bf16x2_t); p[j] = __builtin_bit_cast(unsigned, b); }
    return __builtin_bit_cast(bf16x8, p);
}
__device__ __forceinline__ int tile_row(bool latent, int b, int t) { return latent ? (t < 4 ? MLAT + b * CTXL + 64 * t : b * SEQ + 64 * (t - 4)) : (MLAT + b * CTXL + 64 * t); }

__device__ __forceinline__ void attn_unit(LAS unsigned char* lds, const bf16* Z, bf16* MIX, int b, int h, int qrow0, int NT, bool latent, float lam, float oscale, const float* gsub, int tid, int lane, int wid) {
    const int r32 = lane & 31, hi = lane >> 5, qg = wid >> 1, s = wid & 1;
    const unsigned lds0 = (unsigned)(uintptr_t)lds;
    const int kkey = 8 * wid + (lane >> 3), kcs = (lane & 7) ^ ((kkey >> 1) & 7);
    const int ksrc = kkey * INW + 1024 + (2 * h) * 64 + kcs * 8;
    const int pc0 = wid, pc1 = wid + 8;
    const int vsrc0 = (16 * (pc0 & 3) + (lane >> 2)) * INW + 1536 + h * 128 + (pc0 >> 2) * 32 + (lane & 3) * 8;
    const int vsrc1 = (16 * (pc1 & 3) + (lane >> 2)) * INW + 1536 + h * 128 + (pc1 >> 2) * 32 + (lane & 3) * 8;
#define ATT_DMA(t, bo_) do { const bf16* base_ = Z + (size_t)tile_row(latent, b, (t)) * INW; const unsigned d_ = lds0 + (unsigned)(bo_); \
        glds16(base_ + ksrc, (unsigned)__builtin_amdgcn_readfirstlane(d_ + K1_OFF + wid * 1024)); glds16(base_ + ksrc + 64, (unsigned)__builtin_amdgcn_readfirstlane(d_ + K2_OFF + wid * 1024)); \
        glds16(base_ + vsrc0, (unsigned)__builtin_amdgcn_readfirstlane(d_ + V_OFF + pc0 * 1024)); glds16(base_ + vsrc1, (unsigned)__builtin_amdgcn_readfirstlane(d_ + V_OFF + pc1 * 1024)); } while (0)
#define ATT_WAIT_BAR(N) asm volatile("s_waitcnt vmcnt(" #N ") lgkmcnt(0)\n\ts_barrier" ::: "memory")
    ATT_DMA(0, 0); ATT_DMA(1, BUF); ATT_DMA(2, 2 * BUF);
    bf16x8 qr[4];
    { const bf16* Qp = Z + (size_t)(qrow0 + qg * 32 + r32) * INW + 512 + (2 * h + s) * 64 + hi * 8;
#pragma unroll
      for (int d0 = 0; d0 < 4; ++d0) qr[d0] = *(const bf16x8*)(Qp + d0 * 16); }
    asm volatile("" : "+v"(qr[0]), "+v"(qr[1]), "+v"(qr[2]), "+v"(qr[3]));
    ATT_WAIT_BAR(0);
    float m = 0.f, l = 0.f;
    f32x16 o[4];
#pragma unroll
    for (int d0 = 0; d0 < 4; ++d0)
#pragma unroll
        for (int i = 0; i < 16; ++i) o[d0][i] = 0.f;
    LAS float* scr = (LAS float*)(lds + SCR_OFF) + wid * 64;
    const int kbase = s ? K2_OFF : K1_OFF;
    const int vlane = (4 * hi + ((lane & 15) >> 2)) * 64 + ((lane >> 4) & 1) * 32 + (lane & 3) * 8;
    const int klane = kbase + r32 * 128;
    const int ksw = (r32 >> 1) & 7;
#define ATT_TR(p_) __builtin_bit_cast(s16x4, __builtin_amdgcn_ds_read_tr16_b64_v4i16((LAS v4i16_t*)(p_)))
#define ATT_VF(a_, i_) ((bf16x8){a_[2 * (i_)][0], a_[2 * (i_)][1], a_[2 * (i_)][2], a_[2 * (i_)][3], a_[2 * (i_) + 1][0], a_[2 * (i_) + 1][1], a_[2 * (i_) + 1][2], a_[2 * (i_) + 1][3]})
#define ATT_KLOAD(bo_) do { _Pragma("unroll") for (int d0 = 0; d0 < 4; ++d0) { const LAS unsigned char* ka = lds + (bo_) + klane + (((2 * d0 + hi) ^ ksw) * 16); \
            kf[2 * d0] = *(const LAS bf16x8*)ka; kf[2 * d0 + 1] = *(const LAS bf16x8*)(ka + 4096); } } while (0)
#define ATT_VLOAD(dst_, ks_) do { _Pragma("unroll") for (int d0 = 0; d0 < 4; ++d0) { const LAS unsigned char* vp = lds + bo + V_OFF + d0 * 4096 + (ks_) * 1024 + vlane; \
            dst_[d0 * 2] = ATT_TR(vp); dst_[d0 * 2 + 1] = ATT_TR(vp + 512); } } while (0)
#define ATT_PV(src_, ks_) do { _Pragma("unroll") for (int d0 = 0; d0 < 4; ++d0) o[d0] = __builtin_amdgcn_mfma_f32_32x32x16_bf16(pa[ks_], ATT_VF(src_, d0), o[d0], 0, 0, 0); } while (0)
#define ATT_QK(P0_, P1_) do { _Pragma("unroll") for (int i = 0; i < 16; ++i) { P0_[i] = 0.f; P1_[i] = 0.f; } \
        _Pragma("unroll") for (int d0 = 0; d0 < 4; ++d0) { P0_ = __builtin_amdgcn_mfma_f32_32x32x16_bf16(kf[2 * d0], qr[d0], P0_, 0, 0, 0); P1_ = __builtin_amdgcn_mfma_f32_32x32x16_bf16(kf[2 * d0 + 1], qr[d0], P1_, 0, 0, 0); } } while (0)
    f32x16 p0, p1;
#define ATT_ROWMAX(P0_, P1_, OUT_) do { float rm_ = fmaxf(P0_[0], P1_[0]); _Pragma("unroll") for (int i = 1; i < 16; ++i) rm_ = fmaxf(rm_, fmaxf(P0_[i], P1_[i])); OUT_ = fmaxf(rm_, shfl_xor_l(rm_, 32, lane)); } while (0)
    { bf16x8 kf[8]; ATT_KLOAD(0); ATT_QK(p0, p1); }
    float rm; ATT_ROWMAX(p0, p1, rm);
    int bo = 0, bo1 = BUF, bo2 = 2 * BUF, bo3 = 3 * BUF;
    for (int t = 0; t < NT; ++t) {
        if (t + 3 < NT) ATT_DMA(t + 3, bo3);
        bf16x8 kf[8]; ATT_KLOAD(bo1);
        s16x4 va[8], vb[8];
        ATT_VLOAD(va, 0);
        __builtin_amdgcn_sched_barrier(0);
        const bool first = (t == 0);
        if (first || __any(rm > 8.0f)) {
            const float dl = first ? rm : fmaxf(rm, 0.f);
            const float al = __builtin_amdgcn_exp2f(-dl);
            m += dl; l *= al;
#pragma unroll
            for (int i = 0; i < 16; ++i) { p0[i] -= dl; p1[i] -= dl; }
            if (hi == 0) scr[r32] = al;
            __builtin_amdgcn_wave_barrier();
#pragma unroll
            for (int i = 0; i < 16; ++i) { const float a = scr[crow(i, hi)];
#pragma unroll
                for (int d0 = 0; d0 < 4; ++d0) o[d0][i] *= a; }
            __builtin_amdgcn_wave_barrier();
        }
        __builtin_amdgcn_sched_barrier(0);
        f32x16 n0, n1;
        ATT_QK(n0, n1);
        f32x2 sacc = {0.f, 0.f};
#pragma unroll
        for (int i = 0; i < 16; i += 2) { p0[i] = __builtin_amdgcn_exp2f(p0[i]); p0[i + 1] = __builtin_amdgcn_exp2f(p0[i + 1]); sacc += (f32x2){p0[i], p0[i + 1]}; }
        bf16x8 pa[4]; pa[0] = pack8(p0, 0); pa[1] = pack8(p0, 1);
        __builtin_amdgcn_sched_barrier(0);
        ATT_VLOAD(vb, 1);
        ATT_PV(va, 0);
#pragma unroll
        for (int i = 0; i < 16; i += 2) { p1[i] = __builtin_amdgcn_exp2f(p1[i]); p1[i + 1] = __builtin_amdgcn_exp2f(p1[i + 1]); sacc += (f32x2){p1[i], p1[i + 1]}; }
        pa[2] = pack8(p1, 0); pa[3] = pack8(p1, 1);
        l += sacc.x + sacc.y;
        __builtin_amdgcn_sched_barrier(0);
        ATT_VLOAD(va, 2);
        __builtin_amdgcn_sched_barrier(0);
        ATT_PV(vb, 1);
        __builtin_amdgcn_sched_barrier(0);
        ATT_VLOAD(vb, 3);
        __builtin_amdgcn_sched_barrier(0);
        ATT_PV(va, 2);
        { const f32x2 nm2 = {-m, -m};
          _Pragma("unroll") for (int i = 0; i < 16; i += 2) { f32x2 a = {n0[i], n0[i + 1]}, c2 = {n1[i], n1[i + 1]}; a += nm2; c2 += nm2; n0[i] = a.x; n0[i + 1] = a.y; n1[i] = c2.x; n1[i + 1] = c2.y; } }
        ATT_PV(vb, 3);
        ATT_ROWMAX(n0, n1, rm);
        if (t + 3 < NT) ATT_WAIT_BAR(4); else ATT_WAIT_BAR(0);
        p0 = n0; p1 = n1;
        { const int tmp_ = bo; bo = bo1; bo1 = bo2; bo2 = bo3; bo3 = tmp_; }
    }
#undef ATT_ROWMAX
#undef ATT_KLOAD
#undef ATT_VLOAD
#undef ATT_PV
#undef ATT_QK
#undef ATT_TR
#undef ATT_VF
#undef ATT_DMA
#undef ATT_WAIT_BAR
    l += shfl_xor_l(l, 32, lane);
    if (hi == 0) scr[32 + r32] = 1.0f / l;
    __builtin_amdgcn_wave_barrier();
#pragma unroll
    for (int i = 0; i < 16; ++i) { const float a = scr[32 + crow(i, hi)];
#pragma unroll
        for (int d0 = 0; d0 < 4; ++d0) o[d0][i] *= a; }
    LAS float* ex = (LAS float*)lds + qg * 4096 + lane;
    if (s == 1) {
#pragma unroll
        for (int d0 = 0; d0 < 4; ++d0)
#pragma unroll
            for (int i = 0; i < 16; ++i) ex[(d0 * 16 + i) * 64] = o[d0][i];
    }
    __syncthreads();
    if (s == 0) {
        float ssq[16];
#pragma unroll
        for (int i = 0; i < 16; ++i) { float q = 0.f;
#pragma unroll
            for (int d0 = 0; d0 < 4; ++d0) { const float v = o[d0][i] - lam * ex[(d0 * 16 + i) * 64]; o[d0][i] = v; q += v * v; }
            ssq[i] = q; }
#define ATT_DPP_ROR(v_, n_) __builtin_bit_cast(float, __builtin_amdgcn_update_dpp(0, __builtin_bit_cast(int, (v_)), 0x120 + (n_), 0xf, 0xf, false))
#pragma unroll
        for (int i = 0; i < 16; ++i) { float v = ssq[i];
            v += ATT_DPP_ROR(v, 8); v += ATT_DPP_ROR(v, 4); v += ATT_DPP_ROR(v, 2); v += ATT_DPP_ROR(v, 1);
            ssq[i] = v + shfl_xor_l(v, 16, lane); }
#undef ATT_DPP_ROR
        float gs[4];
#pragma unroll
        for (int d0 = 0; d0 < 4; ++d0) gs[d0] = gsub[32 * d0 + r32] * oscale;
#pragma unroll
        for (int i = 0; i < 16; ++i) { const float rn = 1.0f / sqrtf(ssq[i] * (1.0f / 128.0f) + 1e-6f);
            bf16* op = MIX + (size_t)(qrow0 + qg * 32 + crow(i, hi)) * DM + 512 + h * 128 + r32;
#pragma unroll
            for (int d0 = 0; d0 < 4; ++d0) op[32 * d0] = (bf16)f2bf(o[d0][i] * rn * gs[d0]); }
    }
    __syncthreads();
}
}

namespace sg {
struct EpiZ {
    bf16* Z;
    __device__ __forceinline__ void operator()(int r, int c, const f32x4& a, int) const { const float sc = (c >= 512 && c < 1024) ? 0.18033688011112042f : 1.0f;
        v2u w; w.x = pk2(a.x * sc, a.y * sc); w.y = pk2(a.z * sc, a.w * sc); *(v2u*)(Z + (size_t)r * INW + c) = w; }
};
struct EpiSq {
    bf16* O;
    __device__ __forceinline__ void operator()(int r, int c, const f32x4& a, int) const { const float x = fmaxf(a.x, 0.f), y = fmaxf(a.y, 0.f), z = fmaxf(a.z, 0.f), w_ = fmaxf(a.w, 0.f);
        v2u w; w.x = pk2(x * x, y * y); w.y = pk2(z * z, w_ * w_); *(v2u*)(O + (size_t)r * DFF + c) = w; }
};
struct EpiR {
    const float* res32; const bf16* res16; bf16* out16; const float* gate;
    __device__ __forceinline__ void operator()(int r, int c, const f32x4& a, int) const { const f32x4 g = *(const f32x4*)(gate + c); f32x4 x;
        if (res16) { const v2u q = *(const v2u*)(res16 + (size_t)r * DM + c);
            x = (f32x4){__builtin_bit_cast(float, q.x << 16), __builtin_bit_cast(float, q.x & 0xffff0000u), __builtin_bit_cast(float, q.y << 16), __builtin_bit_cast(float, q.y & 0xffff0000u)}; }
        else x = *(const f32x4*)(res32 + (size_t)r * DM + c);
        const f32x4 o = x + g * a;
        v2u w; w.x = pk2(o.x, o.y); w.y = pk2(o.z, o.w); *(v2u*)(out16 + (size_t)r * DM + c) = w; }
};
struct EpiPart {
    float* P;
    __device__ __forceinline__ void operator()(int r, int c, const f32x4& a, int ks) const { *(f32x4*)(P + ((size_t)ks * 1024 + r) * DM + c) = a; }
};
template <int BN, class Epi, int BM = 64>
__device__ __forceinline__ void small_gemm(LAS unsigned char* lds, const bf16* A, const bf16* Bt, int M, int N, int K, const Epi& E, int tid, int lane, int wid, int KS = 1) {
    constexpr int BK = 128, MT = BM / 32, NTN = BN / 64, NAL = BM / 32, NBL = BN / 32, ABYTES = BM * BK * 2, BBYTES = BN * BK * 2, STAGE = ABYTES + BBYTES;
    const int nN = N / BN, nitems = (M / BM) * nN * KS, Kc = K / KS, nk = Kc / BK;
    const int wm = wid >> 2, wn = wid & 3, fr = lane & 15, fq = lane >> 4;
    const int srow = tid >> 4, sch = tid & 15;
    for (int item = blockIdx.x; item < nitems; item += gridDim.x) {
        const int ks = item % KS, tile = item / KS, pm = tile / nN, pn = tile % nN;
        const bf16* Ag = A + (size_t)(pm * BM + srow) * K + ks * Kc + sch * 8; const bf16* Bg = Bt + (size_t)(pn * BN + srow) * K + ks * Kc + sch * 8;
        f32x4 acc[MT][NTN];
#pragma unroll
        for (int m = 0; m < MT; ++m)
#pragma unroll
            for (int n = 0; n < NTN; ++n) acc[m][n] = (f32x4){0.f, 0.f, 0.f, 0.f};
        v4u ra[NAL], rb[NBL], ra2[NAL], rb2[NBL];
#define SG_LOAD(A_, B_, kt_) do { _Pragma("unroll") for (int j = 0; j < NAL; ++j) A_[j] = *(const v4u*)(Ag + (size_t)(32 * j) * K + (kt_) * BK); \
                          _Pragma("unroll") for (int j = 0; j < NBL; ++j) B_[j] = *(const v4u*)(Bg + (size_t)(32 * j) * K + (kt_) * BK); } while (0)
#define SG_STORE(A_, B_, b_) do { _Pragma("unroll") for (int j = 0; j < NAL; ++j) { const int r_ = srow + 32 * j; *(LAS v4u*)(lds + (b_) * STAGE + r_ * 256 + ((sch ^ (r_ & 15)) * 16)) = A_[j]; } \
                          _Pragma("unroll") for (int j = 0; j < NBL; ++j) { const int r_ = srow + 32 * j; *(LAS v4u*)(lds + (b_) * STAGE + ABYTES + r_ * 256 + ((sch ^ (r_ & 15)) * 16)) = B_[j]; } } while (0)
#define SG_COMPUTE(b_) do { const LAS unsigned char* sa = lds + (b_) * STAGE; const LAS unsigned char* sb = sa + ABYTES; \
            _Pragma("unroll") for (int kk = 0; kk < 4; ++kk) { bf16x8 af[MT], bfr[NTN]; \
                _Pragma("unroll") for (int m = 0; m < MT; ++m) { const int r_ = (BM / 2) * wm + 16 * m + fr; af[m] = *(const LAS bf16x8*)(sa + r_ * 256 + (((kk * 4 + fq) ^ (r_ & 15)) * 16)); } \
                _Pragma("unroll") for (int n = 0; n < NTN; ++n) { const int r_ = (BN / 4) * wn + 16 * n + fr; bfr[n] = *(const LAS bf16x8*)(sb + r_ * 256 + (((kk * 4 + fq) ^ (r_ & 15)) * 16)); } \
                _Pragma("unroll") for (int m = 0; m < MT; ++m) _Pragma("unroll") for (int n = 0; n < NTN; ++n) acc[m][n] = __builtin_amdgcn_mfma_f32_16x16x32_bf16(bfr[n], af[m], acc[m][n], 0, 0, 0); } } while (0)
        SG_LOAD(ra, rb, 0); SG_LOAD(ra2, rb2, 1); SG_STORE(ra, rb, 0);
        __syncthreads();
        for (int kt = 0; kt < nk; kt += 2) {
            if (kt + 2 < nk) SG_LOAD(ra, rb, kt + 2);
            SG_COMPUTE(0);
            SG_STORE(ra2, rb2, 1);
            __syncthreads();
            if (kt + 3 < nk) SG_LOAD(ra2, rb2, kt + 3);
            SG_COMPUTE(1);
            if (kt + 2 < nk) SG_STORE(ra, rb, 0);
            __syncthreads();
        }
#undef SG_COMPUTE
#undef SG_LOAD
#undef SG_STORE
#pragma unroll
        for (int m = 0; m < MT; ++m)
#pragma unroll
            for (int n = 0; n < NTN; ++n) E(pm * BM + (BM / 2) * wm + 16 * m + fr, pn * BN + (BN / 4) * wn + 16 * n + 4 * fq, acc[m][n], ks);
    }
}
}

#define XB_TMO      128
#define XB_XCNT(j)  (256  + 64 * (j))
#define XB_XSUB(j)  (1280 + 64 * (j))
#define XB_XGEN(j)  (2304 + 64 * (j))
#define XB_TOP      3328
#define XB_TOPGEN   3392
#define XCD_BAR_WORDS 3456
#define XB_SPIN_CAP (1u << 18)

__device__ __forceinline__ unsigned xb_ld(unsigned* p)              { return __hip_atomic_load(p, __ATOMIC_RELAXED, __HIP_MEMORY_SCOPE_AGENT); }
__device__ __forceinline__ unsigned xb_add(unsigned* p, unsigned v) { return __hip_atomic_fetch_add(p, v, __ATOMIC_RELAXED, __HIP_MEMORY_SCOPE_AGENT); }
__device__ __forceinline__ unsigned xb_xcc_id() { return (unsigned)__builtin_amdgcn_s_getreg((3 << 11) | 20) & 0xFu; }
#define XB_SPIN(cond, bar) do { unsigned _sp = 0; while (cond) { __builtin_amdgcn_s_sleep(1); \
    if ((++_sp & 255u) == 0u) { if (xb_ld(&(bar)[XB_TMO])) break; if (_sp > XB_SPIN_CAP) { atomicAdd(&(bar)[XB_TMO], 1u); break; } } } } while (0)

struct XcdBarrier {
    unsigned* bar; unsigned x;
    volatile LAS unsigned* st;
};

__device__ __forceinline__ XcdBarrier xcd_barrier_post(unsigned* bar, volatile LAS unsigned* st) {
    XcdBarrier b; b.bar = bar; b.x = (unsigned)__builtin_amdgcn_readfirstlane((int)xb_xcc_id()); b.st = st;
    if (threadIdx.x == 0) (void)xb_add(&bar[XB_XCNT(b.x)], 1u);
    return b;
}
__device__ __forceinline__ void xcd_barrier_complete(unsigned* bar, unsigned x, unsigned& nloc, unsigned& nx) {
    const unsigned G = gridDim.x * gridDim.y * gridDim.z;
    unsigned sum, cnt, mine, sp = 0u;
    for (;;) {
        sum = 0u; cnt = 0u; mine = 0u;
#pragma unroll
        for (unsigned j = 0; j < 16; ++j) { const unsigned c = xb_ld(&bar[XB_XCNT(j)]); sum += c; cnt += (c > 0u) ? 1u : 0u; mine = (j == x) ? c : mine; }
        if (sum == G) break;
        __builtin_amdgcn_s_sleep(1);
        if ((++sp & 255u) == 0u) { if (xb_ld(&bar[XB_TMO])) break; if (sp > XB_SPIN_CAP) { atomicAdd(&bar[XB_TMO], 1u); break; } }
    }
    nloc = mine > 0u ? mine : 1u; nx = cnt > 0u ? cnt : 1u;
}

__device__ __forceinline__ void xcd_barrier(const XcdBarrier& b) {
    asm volatile("s_waitcnt vmcnt(0)" ::: "memory");
    __syncthreads();
    if (threadIdx.x == 0) {
        unsigned* bar = b.bar;
        unsigned bx_ = b.x; asm volatile("" : "+s"(bx_));
        __builtin_amdgcn_s_waitcnt(0);
        unsigned nloc = b.st[0], nx = b.st[1];
        if (nloc == 0u) { xcd_barrier_complete(bar, bx_, nloc, nx); b.st[0] = nloc; b.st[1] = nx; }
        const unsigned old = xb_add(&bar[XB_XSUB(bx_)], 1u);
        const unsigned gen = old / nloc;
        if (old + 1u == (gen + 1u) * nloc) {
            __builtin_amdgcn_fence(__ATOMIC_RELEASE, "agent");
            asm volatile("s_waitcnt vmcnt(0)" ::: "memory");
            const unsigned og = xb_add(&bar[XB_TOP], 1u);
            const unsigned tg = og / nx;
            if (og + 1u == (tg + 1u) * nx) xb_add(&bar[XB_TOPGEN], 1u);
            else XB_SPIN(xb_ld(&bar[XB_TOPGEN]) == tg, bar);
            __builtin_amdgcn_fence(__ATOMIC_ACQUIRE, "agent");
            xb_add(&bar[XB_XGEN(bx_)], 1u);
            asm volatile("s_waitcnt vmcnt(0)" ::: "memory");
        } else {
            XB_SPIN(xb_ld(&bar[XB_XGEN(bx_)]) == gen, bar);
            __builtin_amdgcn_fence(__ATOMIC_ACQUIRE, "agent");
            asm volatile("s_waitcnt vmcnt(0)" ::: "memory");
        }
    }
    __syncthreads();
}

__global__ void __launch_bounds__(512, 2) mega_fwd(Params p) {
    extern __shared__ __attribute__((aligned(16))) unsigned char lds_raw[];
    LAS unsigned char* lds = (LAS unsigned char*)lds_raw;
    cg::grid_group grid = cg::this_grid();
    int tid = threadIdx.x, lane = tid & 63, wid = __builtin_amdgcn_readfirstlane(tid >> 6);
#define OPAQUE_TID() do { tid = threadIdx.x; asm volatile("" : "+v"(tid)); lane = tid & 63; wid = __builtin_amdgcn_readfirstlane(tid >> 6); } while (0)
    const int G = gridDim.x, bx = blockIdx.x;
    const int vcu = (G % 8 == 0) ? (bx % 8) * (G / 8) + bx / 8 : bx;
    unsigned char* ws = p.ws;
    if (tid < 16) ((LAS unsigned*)(lds + LDS_CTL))[tid] = 0u;
    __syncthreads();
    const XcdBarrier xbar = xcd_barrier_post((unsigned*)(ws + WS_BAR), (volatile LAS unsigned*)(lds + LDS_CTL));
    float* ada = (float*)(ws + WS_ADA);
    const float* cosT = (const float*)(ws + WS_ROPE); const float* sinT = cosT + 4096 * 32;
    bf16* X16 = (bf16*)(ws + WS_X);
    bf16* H = (bf16*)(ws + WS_H); bf16* Z = (bf16*)(ws + WS_Z); bf16* MIX = (bf16*)(ws + WS_MIX); bf16* A = (bf16*)(ws + WS_A);

#ifndef NO_PRO
    for (int rep_ = 0; rep_ < REP_N; ++rep_) { prologue(p, lds, tid, lane, wid); __syncthreads(); }
#endif
    if (ws == nullptr) grid.sync();
    xcd_barrier(xbar);

    for (int l = 0; l < NLAYER; ++l) {
        const bool last = (l == NLAYER - 1);
        const int rows2 = last ? MLAT : MTOT;
        const unsigned char* wl = ws + WS_W + (size_t)l * W_LAYER;
        const float* adal = ada + (size_t)l * 5 * NADA;
        const bool l0 = (l == 0);

        OPAQUE_TID();
        if (l0) norm_mod_phase(p.x, p.ctx, p.g_mix + l * DM, adal, 0, H, MTOT, lane, wid);
        else norm_mod_phase16(X16, p.g_mix + l * DM, adal, 0, H, MTOT, lane, wid, (const float*)(ws + WS_PART), ada + ((size_t)(l - 1) * 5 + 4) * NADA + 5 * DM);
        GSYNC();
        { pg8::Gemm g{H, (const bf16*)(wl + WO_IN), MLAT, INW, DM}; pg8::StaticOrder S; S.init(MLAT, INW, G, bx);
          pg8::EpiInProj E{Z, cosT, sinT};
          for (int rep_ = 0; rep_ < REP_G; ++rep_) pg8::gemm_phase<pg8::EpiInProj, pg8::StaticOrder, true, true>(lds, g, S, E); }
        { OPAQUE_TID(); sg::EpiZ E{Z + (size_t)MLAT * INW};
          sg::small_gemm<128, sg::EpiZ>(lds, H + (size_t)MLAT * DM, (const bf16*)(wl + WO_IN), MTOT - MLAT, INW, DM, E, tid, lane, wid); }
        GSYNC();
        OPAQUE_TID();
        {
            float lam, lam_init = 0.8f - 0.6f * __expf(-0.3f * (float)l);
            { const float a = p.lq1[l * 64 + lane] * p.lk1[l * 64 + lane], c2 = p.lq2[l * 64 + lane] * p.lk2[l * 64 + lane];
              lam = __expf(wave_sum(a, lane)) - __expf(wave_sum(c2, lane)) + lam_init; }
            const float oscale = 1.0f - lam_init;
            const float* gsub = p.g_sub + l * 128;
            _Pragma("nounroll") for (int rep_ = 0; rep_ < REP_ATT; ++rep_) {
            const int natt = last ? 512 : 544;
            _Pragma("nounroll") for (int u = vcu; u < natt; u += G) {
                OPAQUE_TID();
                int b, h, qrow0, NT; bool latent;
                if (u < 512) { const int bh = u >> 5, qb = u & 31; b = bh >> 2; h = bh & 3; qrow0 = b * SEQ + qb * 128; NT = 68; latent = true; }
                else { const int v = u - 512, bh = v >> 1, qb = v & 1; b = bh >> 2; h = bh & 3; qrow0 = MLAT + b * CTXL + qb * 128; NT = 4; latent = false; }
                att::attn_unit(lds, Z, MIX, b, h, qrow0, NT, latent, lam, oscale, gsub, tid, lane, wid);
            }
            const int nctx = last ? 0 : 32, NE = nctx + (last ? 256 : 272);
            _Pragma("nounroll") for (int r = 0; r * G < NE; ++r) { const int e = r * G + ((r & 1) ? G - 1 - vcu : vcu);
                if (e >= nctx && e < NE) { OPAQUE_TID(); pool_unit(lds, Z, MIX, (const bf16*)(wl + WO_P), p.s_pool + l * 512, e - nctx, tid, lane, wid); } }
            }
        }
        GSYNC();
        { pg8::Gemm g{MIX, (const bf16*)(wl + WO_OUT), MLAT, DM, DM}; pg8::StaticOrder S; S.init(MLAT, DM, G, bx);
          pg8::EpiRes E{p.x, p.ctx, l0 ? (const bf16*)nullptr : (const bf16*)X16, X16, adal + 2 * DM};
          pg8::gemm_phase<pg8::EpiRes, pg8::StaticOrder, true, true>(lds, g, S, E); }
        if (!last) { OPAQUE_TID(); sg::EpiR E{p.ctx, l0 ? (const bf16*)nullptr : (const bf16*)(X16 + (size_t)MLAT * DM), X16 + (size_t)MLAT * DM, adal + 4 * NADA + 2 * DM};
          sg::small_gemm<64, sg::EpiR>(lds, MIX + (size_t)MLAT * DM, (const bf16*)(wl + WO_OUT), MTOT - MLAT, DM, DM, E, tid, lane, wid); }
        GSYNC();
        OPAQUE_TID();
        norm_mod_phase16(X16, p.g_mlp + l * DM, adal, 3, H, rows2, lane, wid);
        GSYNC();
        { pg8::Gemm g{H, (const bf16*)(wl + WO_1), MLAT, DFF, DM}; pg8::StaticOrder S; S.init(MLAT, DFF, G, bx);
          pg8::EpiSqRelu E{A, DFF};
          for (int rep_ = 0; rep_ < REP_G; ++rep_) pg8::gemm_phase<pg8::EpiSqRelu, pg8::StaticOrder, true, true>(lds, g, S, E); }
        if (!last) { OPAQUE_TID(); sg::EpiSq E{A + (size_t)MLAT * DFF};
          sg::small_gemm<128, sg::EpiSq, 128>(lds, H + (size_t)MLAT * DM, (const bf16*)(wl + WO_1), MTOT - MLAT, DFF, DM, E, tid, lane, wid); }
        GSYNC();
        { pg8::Gemm g{A, (const bf16*)(wl + WO_2), MLAT, DM, DFF}; pg8::StaticOrder S; S.init(MLAT, DM, G, bx);
          pg8::EpiRes E{p.x, p.ctx, X16, X16, adal + 5 * DM};
          pg8::gemm_phase<pg8::EpiRes, pg8::StaticOrder, true, true>(lds, g, S, E); }
        if (!last) { OPAQUE_TID(); sg::EpiPart E{(float*)(ws + WS_PART)};
          sg::small_gemm<128, sg::EpiPart, 128>(lds, A + (size_t)MLAT * DFF, (const bf16*)(wl + WO_2), MTOT - MLAT, DM, DFF, E, tid, lane, wid, 4); }
        GSYNC();
    }
    OPAQUE_TID();
    final_norm_phase(X16, p.g_final, p.out, lane, wid);
}

extern "C" void kernel_launch(void* const* d_in, const int* in_sizes, int n_in, void* d_out, int out_size, void* d_ws, size_t ws_size, hipStream_t stream) {
    static int grid = 0;
    if (grid == 0) {
        if (n_in != 20 || ws_size < WS_END) { fprintf(stderr, "kernel_launch: unexpected n_in %d or ws_size %zu (< %zu)\n", n_in, ws_size, (size_t)WS_END); }
        int dev = 0, cus = 0, per_cu = 0;
        (void)hipGetDevice(&dev);
        (void)hipDeviceGetAttribute(&cus, hipDeviceAttributeMultiprocessorCount, dev);
        (void)hipFuncSetAttribute((const void*)mega_fwd, hipFuncAttributeMaxDynamicSharedMemorySize, LDS_BYTES);
        (void)hipOccupancyMaxActiveBlocksPerMultiprocessor(&per_cu, (const void*)mega_fwd, 512, LDS_BYTES);
        if (per_cu < 1) per_cu = 1;
        grid = cus * per_cu;
        fprintf(stderr, "kernel_launch: grid %d (cus %d x %d)\n", grid, cus, per_cu);
    }
    (void)hipMemsetAsync((unsigned char*)d_ws + WS_BAR, 0, WS_BAR_BYTES, stream);
    Params p{};
    const float** pp = (const float**)&p;
    for (int i = 0; i < 20; ++i) pp[i] = (const float*)d_in[i];
    p.out = (float*)d_out; p.ws = (unsigned char*)d_ws;
    void* args[] = {&p};
    hipError_t e = hipLaunchCooperativeKernel((const void*)mega_fwd, dim3(grid), dim3(512), args, LDS_BYTES, stream);
    if (e != hipSuccess) fprintf(stderr, "cooperative launch failed: %s (grid %d)\n", hipGetErrorString(e), grid);
}
```
